# Optimizing an MI355X kernel written in HIP

```python
import math
import jax, jax.numpy as jnp
from jax import lax
import numpy as np

D_MODEL = 2048
BATCH = 4
SEQ = 2048
DEPTH = 2

N_MIXERS = 2
N_LAYERS_A = (DEPTH + 1) // 2
N_LAYERS_B = DEPTH // 2
NORM_EPS = 1e-6
PLE_DIM = 256
D_FF = -(-8 * D_MODEL // (3 * 256)) * 256
LRU_WIDTH = D_MODEL
LRU_HEADS = 8
LRU_BLOCK = LRU_WIDTH // LRU_HEADS
CONV_WIDTH = 4
LRU_C = 8.0
SSD_EXPAND = 2
SSD_INNER = SSD_EXPAND * D_MODEL
SSD_HEAD_DIM = 64
SSD_HEADS = SSD_INNER // SSD_HEAD_DIM
SSD_GROUPS = 8
SSD_HEADS_PER_GROUP = SSD_HEADS // SSD_GROUPS
SSD_STATE = 128
SSD_CHUNK = 128
SSD_CONV_DIM = SSD_INNER + 2 * SSD_GROUPS * SSD_STATE
SSD_IN_DIM = SSD_INNER + SSD_CONV_DIM + SSD_HEADS
SSD_NORM_GROUP = SSD_INNER // SSD_GROUPS

kernel_name = "hybrid_rglru_ssd_swiglu_ple"


def rmsnorm(x, g):
    xf = x.astype(jnp.float32)
    y = xf * lax.rsqrt(jnp.mean(xf * xf, axis=-1, keepdims=True) + NORM_EPS)
    return (y * g.astype(jnp.float32)).astype(x.dtype)


def causal_dwconv(x, w, b):
    W = w.shape[0]
    S = x.shape[1]
    xp = jnp.pad(x, ((0, 0), (W - 1, 0), (0, 0)))
    y = b + xp[:, 0:S] * w[0]
    for k in range(1, W):
        y = y + xp[:, k:k + S] * w[k]
    return y


def _lin_combine(c1, c2):
    a1, b1 = c1
    a2, b2 = c2
    return (a1 * a2, a2 * b1 + b2)


def rglru_mixer(u, w_in, conv_w, conv_b, w_gate_r, b_gate_r, w_gate_i, b_gate_i, lam, w_out):
    bsz, S, _ = u.shape
    xy = u @ w_in
    xr, yg = jnp.split(xy, 2, axis=-1)
    yg = jax.nn.gelu(yg, approximate=True)
    xr = causal_dwconv(xr, conv_w, conv_b)
    xb = xr.reshape(bsz, S, LRU_HEADS, LRU_BLOCK)
    r = jax.nn.sigmoid(jnp.einsum('bshi,hij->bshj', xb, w_gate_r) + b_gate_r).reshape(bsz, S, LRU_WIDTH)
    i = jax.nn.sigmoid(jnp.einsum('bshi,hij->bshj', xb, w_gate_i) + b_gate_i).reshape(bsz, S, LRU_WIDTH)
    log_a = -LRU_C * r.astype(jnp.float32) * jax.nn.softplus(-lam.astype(jnp.float32))
    a = jnp.exp(log_a)
    mult = jnp.sqrt(-jnp.expm1(2.0 * log_a))
    bterm = mult * (i * xr).astype(jnp.float32)
    _, hs = lax.associative_scan(_lin_combine, (a, bterm), axis=1)
    y = hs.astype(u.dtype) * yg
    return y @ w_out


def segsum(x):
    T = x.shape[-1]
    cs = jnp.cumsum(x, axis=-1)
    diff = cs[..., :, None] - cs[..., None, :]
    mask = jnp.tril(jnp.ones((T, T), dtype=bool))
    return jnp.where(mask, diff, -jnp.inf)


def ssd_scan(x, dt, A, Bm, Cm):
    b, S, H, P = x.shape
    L = SSD_CHUNK
    nc = S // L
    G, E, N = SSD_GROUPS, SSD_HEADS_PER_GROUP, SSD_STATE
    X = (x * dt[..., None]).reshape(b, nc, L, G, E, P)
    Adt = (A * dt).reshape(b, nc, L, G, E).transpose(0, 3, 4, 1, 2)
    Bc = Bm.reshape(b, nc, L, G, N)
    Cc = Cm.reshape(b, nc, L, G, N)
    A_cs = jnp.cumsum(Adt, axis=-1)
    Lmat = jnp.exp(segsum(Adt))
    CB = jnp.einsum('bclgn,bcsgn->bgcls', Cc, Bc)
    scores = CB[:, :, None] * Lmat
    y_diag = jnp.einsum('bgecls,bcsgep->bclgep', scores, X)
    decay_states = jnp.exp(A_cs[..., -1:] - A_cs)
    states = jnp.einsum('bclgn,bgecl,bclgep->bcgepn', Bc, decay_states, X)
    states = jnp.concatenate([jnp.zeros_like(states[:, :1]), states], axis=1)
    chunk_tot = jnp.pad(A_cs[..., -1], ((0, 0), (0, 0), (0, 0), (1, 0)))
    decay_chunk = jnp.exp(segsum(chunk_tot))
    states_in = jnp.einsum('bgezc,bcgepn->bzgepn', decay_chunk, states)[:, :-1]
    y_off = jnp.einsum('bclgn,bcgepn,bgecl->bclgep', Cc, states_in, jnp.exp(A_cs))
    return (y_diag + y_off).reshape(b, S, H, P)


def ssd_mixer(u, w_in, conv_w, conv_b, dt_bias, a_log, d_skip, norm_g, w_out):
    b, S, _ = u.shape
    G, N = SSD_GROUPS, SSD_STATE
    zxbcdt = u @ w_in
    z = zxbcdt[..., :SSD_INNER]
    xbc = zxbcdt[..., SSD_INNER:SSD_INNER + SSD_CONV_DIM]
    dt = zxbcdt[..., SSD_INNER + SSD_CONV_DIM:]
    xbc = jax.nn.silu(causal_dwconv(xbc, conv_w, conv_b))
    xs = xbc[..., :SSD_INNER].reshape(b, S, SSD_HEADS, SSD_HEAD_DIM).astype(jnp.float32)
    Bm = xbc[..., SSD_INNER:SSD_INNER + G * N].reshape(b, S, G, N).astype(jnp.float32)
    Cm = xbc[..., SSD_INNER + G * N:].reshape(b, S, G, N).astype(jnp.float32)
    dt = jax.nn.softplus(dt.astype(jnp.float32) + dt_bias.astype(jnp.float32))
    A = -jnp.exp(a_log.astype(jnp.float32))
    y = ssd_scan(xs, dt, A, Bm, Cm)
    y = y + d_skip.astype(jnp.float32)[:, None] * xs
    y = y.reshape(b, S, SSD_INNER) * jax.nn.silu(z.astype(jnp.float32))
    yg = y.reshape(b, S, SSD_GROUPS, SSD_NORM_GROUP)
    yg = yg * lax.rsqrt(jnp.mean(yg * yg, axis=-1, keepdims=True) + NORM_EPS)
    y = (yg.reshape(b, S, SSD_INNER) * norm_g.astype(jnp.float32)).astype(u.dtype)
    return y @ w_out


def swiglu(u, w_gate, w_up, w_down):
    return (jax.nn.silu(u @ w_gate) * (u @ w_up)) @ w_down


def setup_inputs(seed: int = 0) -> dict:
    key = jax.random.key(seed)
    ks = jax.random.split(key, 32)
    f32 = jnp.float32
    nrm = lambda k, shape, scale: jax.random.normal(k, shape, f32) * scale
    gain = lambda k, shape: 1.0 + 0.02 * jax.random.normal(k, shape, f32)
    x = jax.random.normal(ks[0], (BATCH, SEQ, D_MODEL), f32)
    p = jax.random.normal(ks[1], (DEPTH, BATCH, SEQ, PLE_DIM), f32)
    norm_mix_g = gain(ks[2], (DEPTH, D_MODEL))
    norm_ffn_g = gain(ks[3], (DEPTH, D_MODEL))
    norm_ple_g = gain(ks[4], (DEPTH, D_MODEL))
    final_norm_g = gain(ks[5], (D_MODEL,))
    a_w_in = nrm(ks[6], (N_LAYERS_A, D_MODEL, 2 * LRU_WIDTH), D_MODEL ** -0.5)
    a_conv_w = nrm(ks[7], (N_LAYERS_A, CONV_WIDTH, LRU_WIDTH), CONV_WIDTH ** -0.5)
    a_conv_b = nrm(ks[8], (N_LAYERS_A, LRU_WIDTH), 0.01)
    a_w_gate_r = nrm(ks[9], (N_LAYERS_A, LRU_HEADS, LRU_BLOCK, LRU_BLOCK), LRU_BLOCK ** -0.5)
    a_b_gate_r = nrm(ks[10], (N_LAYERS_A, LRU_HEADS, LRU_BLOCK), 0.01)
    a_w_gate_i = nrm(ks[11], (N_LAYERS_A, LRU_HEADS, LRU_BLOCK, LRU_BLOCK), LRU_BLOCK ** -0.5)
    a_b_gate_i = nrm(ks[12], (N_LAYERS_A, LRU_HEADS, LRU_BLOCK), 0.01)
    u_a = jax.random.uniform(ks[13], (N_LAYERS_A, LRU_WIDTH), f32, 0.9, 0.999)
    s_a = u_a ** (1.0 / LRU_C)
    a_lambda = jnp.log(s_a) - jnp.log1p(-s_a)
    a_w_out = nrm(ks[14], (N_LAYERS_A, LRU_WIDTH, D_MODEL), LRU_WIDTH ** -0.5)
    b_w_in = nrm(ks[15], (N_LAYERS_B, D_MODEL, SSD_IN_DIM), D_MODEL ** -0.5)
    b_conv_w = nrm(ks[16], (N_LAYERS_B, CONV_WIDTH, SSD_CONV_DIM), CONV_WIDTH ** -0.5)
    b_conv_b = nrm(ks[17], (N_LAYERS_B, SSD_CONV_DIM), 0.01)
    dt0 = jnp.exp(jax.random.uniform(ks[18], (N_LAYERS_B, SSD_HEADS), f32, math.log(1e-3), math.log(1e-1)))
    b_dt_bias = dt0 + jnp.log(-jnp.expm1(-dt0))
    b_a_log = jnp.log(jax.random.uniform(ks[19], (N_LAYERS_B, SSD_HEADS), f32, 1.0, 16.0))
    b_d_skip = 1.0 + 0.1 * jax.random.normal(ks[20], (N_LAYERS_B, SSD_HEADS), f32)
    b_norm_g = gain(ks[21], (N_LAYERS_B, SSD_INNER))
    b_w_out = nrm(ks[22], (N_LAYERS_B, SSD_INNER, D_MODEL), SSD_INNER ** -0.5)
    ffn_w_gate = nrm(ks[23], (DEPTH, D_MODEL, D_FF), D_MODEL ** -0.5)
    ffn_w_up = nrm(ks[24], (DEPTH, D_MODEL, D_FF), D_MODEL ** -0.5)
    ffn_w_down = nrm(ks[25], (DEPTH, D_FF, D_MODEL), D_FF ** -0.5)
    ple_w_proj = nrm(ks[26], (DEPTH, PLE_DIM, D_MODEL), PLE_DIM ** -0.5)
    ple_w_gate = nrm(ks[27], (DEPTH, D_MODEL, D_MODEL), D_MODEL ** -0.5)
    return {"x": x, "p": p, "norm_mix_g": norm_mix_g, "norm_ffn_g": norm_ffn_g,
            "norm_ple_g": norm_ple_g, "final_norm_g": final_norm_g,
            "a_w_in": a_w_in, "a_conv_w": a_conv_w, "a_conv_b": a_conv_b,
            "a_w_gate_r": a_w_gate_r, "a_b_gate_r": a_b_gate_r,
            "a_w_gate_i": a_w_gate_i, "a_b_gate_i": a_b_gate_i,
            "a_lambda": a_lambda, "a_w_out": a_w_out,
            "b_w_in": b_w_in, "b_conv_w": b_conv_w, "b_conv_b": b_conv_b,
            "b_dt_bias": b_dt_bias, "b_a_log": b_a_log, "b_d_skip": b_d_skip,
            "b_norm_g": b_norm_g, "b_w_out": b_w_out,
            "ffn_w_gate": ffn_w_gate, "ffn_w_up": ffn_w_up, "ffn_w_down": ffn_w_down,
            "ple_w_proj": ple_w_proj, "ple_w_gate": ple_w_gate}


def reference(x, p, norm_mix_g, norm_ffn_g, norm_ple_g, final_norm_g,
              a_w_in, a_conv_w, a_conv_b, a_w_gate_r, a_b_gate_r, a_w_gate_i, a_b_gate_i,
              a_lambda, a_w_out,
              b_w_in, b_conv_w, b_conv_b, b_dt_bias, b_a_log, b_d_skip, b_norm_g, b_w_out,
              ffn_w_gate, ffn_w_up, ffn_w_down, ple_w_proj, ple_w_gate):
    h = x
    for i in range(DEPTH):
        u = rmsnorm(h, norm_mix_g[i])
        j = i // N_MIXERS
        if i % N_MIXERS == 0:
            m = rglru_mixer(u, a_w_in[j], a_conv_w[j], a_conv_b[j], a_w_gate_r[j], a_b_gate_r[j],
                            a_w_gate_i[j], a_b_gate_i[j], a_lambda[j], a_w_out[j])
        else:
            m = ssd_mixer(u, b_w_in[j], b_conv_w[j], b_conv_b[j], b_dt_bias[j], b_a_log[j],
                          b_d_skip[j], b_norm_g[j], b_w_out[j])
        h = h + m
        h = h + swiglu(rmsnorm(h, norm_ffn_g[i]), ffn_w_gate[i], ffn_w_up[i], ffn_w_down[i])
        gate = jax.nn.sigmoid(rmsnorm(h, norm_ple_g[i]) @ ple_w_gate[i])
        h = h + gate * (p[i].astype(h.dtype) @ ple_w_proj[i])
    return rmsnorm(h, final_norm_g)
```

```cpp
#include <hip/hip_runtime.h>
#include <hip/hip_cooperative_groups.h>
#include <cstdio>
#include <cstdint>
namespace cg = cooperative_groups;

#ifndef ONE_LAUNCH
#define ONE_LAUNCH 1
#endif

#define LAS __attribute__((address_space(3)))
typedef unsigned short bf16_t;
typedef short bf16x8 __attribute__((ext_vector_type(8)));
typedef float f32x4 __attribute__((ext_vector_type(4)));
typedef float f32x2 __attribute__((ext_vector_type(2)));
typedef unsigned u32x4 __attribute__((ext_vector_type(4)));
typedef unsigned u32x2 __attribute__((ext_vector_type(2)));
typedef unsigned long long ss_t;
__device__ __forceinline__ void ss_add(ss_t* p, float v) { (void)__hip_atomic_fetch_add(p, (ss_t)(v * 1048576.0f), __ATOMIC_RELAXED, __HIP_MEMORY_SCOPE_AGENT); }
__device__ __forceinline__ float ss_rstd(const ss_t* p) { return rsqrtf((float)(*p) * (1.0f / (1048576.0f * 2048.0f)) + 1e-6f); }

constexpr int T = 8192, D = 2048, SEQ = 2048, DFF = 5632, PLE = 256;
constexpr int SSD_INNER = 4096, SSD_CONV = 6144, SSD_IN = 10304, SSD_IN_PAD = 10496, SSD_H = 64;
constexpr float EPS = 1e-6f;

constexpr size_t MB = 1ull << 20;
constexpr size_t WS_W_IN = 0;
constexpr size_t WS_W_GATE = 16 * MB, WS_W_AOUT = 18 * MB;
constexpr size_t WS_W_BOUT = 41 * MB;
constexpr size_t WS_W_GU = 57 * MB;
constexpr size_t WS_W_D = 101 * MB;
constexpr size_t WS_W_PG = 123 * MB;
constexpr size_t WS_W_PP = 131 * MB;
constexpr size_t WS_W_PG1 = 26 * MB, WS_W_PP1 = 34 * MB;
constexpr size_t WS_WB_IN = 132 * MB;
constexpr size_t WS_WB_OUT = 173 * MB;
constexpr size_t WS_PB = 196 * MB;
constexpr size_t WS_PP = 204 * MB;
constexpr size_t WS_U = 236 * MB;
constexpr size_t WS_AR = 268 * MB;
constexpr size_t WS_XRPRE = WS_AR, WS_YG = WS_AR + 32 * MB, WS_XRC = WS_AR + 64 * MB, WS_AA = WS_AR + 96 * MB, WS_BB = WS_AR + 160 * MB, WS_Y = WS_AR;
constexpr size_t WS_ACT = WS_AR;
constexpr size_t WS_Z = WS_AR, WS_XBCPRE = WS_AR + 64 * MB, WS_XBC = WS_AR + 160 * MB, WS_DT = WS_AR + 256 * MB, WS_YS = WS_AR + 64 * MB;
constexpr size_t WS_W_GU0 = WS_AR + 192 * MB, WS_W_D0 = WS_AR + 236 * MB;
constexpr size_t WS_SPT = WS_AR + 258 * MB + 524288;
constexpr size_t WS_BAR = WS_AR + 258 * MB;
constexpr size_t WS_CNT = WS_BAR + 65536 + 6 * 65536;
constexpr size_t WS_SS = WS_BAR + 65536;
constexpr size_t WS_U2 = WS_PP;
constexpr size_t WS_DTP = WS_U;
constexpr size_t WS_END = WS_AR + 259 * MB;

constexpr int LDS_BYTES = 139264;

__device__ __forceinline__ unsigned cvt_pk_bf16(float lo, float hi) { unsigned r; asm volatile("v_cvt_pk_bf16_f32 %0, %1, %2" : "=v"(r) : "v"(lo), "v"(hi)); return r; }
__device__ __forceinline__ float bf2f(unsigned short v) { return __uint_as_float(((unsigned)v) << 16); }
__device__ __forceinline__ float bflo(unsigned w) { return __uint_as_float(w << 16); }
__device__ __forceinline__ float bfhi(unsigned w) { return __uint_as_float(w & 0xffff0000u); }
__device__ __forceinline__ float fsigmoid(float x) { return __builtin_amdgcn_rcpf(1.0f + __expf(-x)); }
__device__ __forceinline__ float fsilu(float x) { return x * fsigmoid(x); }
__device__ __forceinline__ void sigmoid2(float x0, float x1, float& s0, float& s1) {
    const float d0 = 1.0f + __builtin_amdgcn_exp2f(fminf(x0 * -1.4426950408889634f, 60.f)), d1 = 1.0f + __builtin_amdgcn_exp2f(fminf(x1 * -1.4426950408889634f, 60.f));
    const float rp = __builtin_amdgcn_rcpf(d0 * d1); s0 = rp * d1; s1 = rp * d0; }
__device__ __forceinline__ f32x4 sigmoid4(f32x4 x) { float a, b, c, d; sigmoid2(x[0], x[1], a, b); sigmoid2(x[2], x[3], c, d); return (f32x4){a, b, c, d}; }
__device__ __forceinline__ f32x4 gelu_tanh4(f32x4 v) { const f32x4 z = (v * v * 0.044715f + 1.0f) * v * 1.5957691216057308f; return v * sigmoid4(z); }
__device__ __forceinline__ float fgelu_tanh(float v) { return v * fsigmoid(1.5957691216057308f * (v + 0.044715f * v * v * v)); }
__device__ __forceinline__ float fsoftplus(float x) { return x > 20.f ? x : __logf(1.0f + __expf(x)); }
__device__ __forceinline__ float neg_expm1_small(float x) { return -x * (1.0f + x * (0.5f + x * (0.16666667f + x * (0.041666668f + x * (0.0083333338f + x * 0.0013888889f))))); }
__device__ __forceinline__ float wave_sum(float v) {
#pragma unroll
    for (int o = 1; o < 64; o <<= 1) v += __shfl_xor(v, o);
    return v;
}

namespace pg8 {
constexpr int BM = 256, BK = 64, HALF = 128, HTB = HALF * BK * 2, STAGE_BYTES = 8 * HTB, NXCD = 8, WGM = 8;
__host__ __device__ __forceinline__ int lds_byte(int r, int c) { const int st = (r >> 4) * 2 + (c >> 5), rr = r & 15, cc = c & 31, ob = rr * 64 + cc * 2; return st * 1024 + (ob ^ (((ob >> 9) & 1) << 5)); }
__host__ __device__ __forceinline__ void stage_rc(int b, int& R, int& C) { const int st = b / 1024, sb = b % 1024, swz = sb ^ (((sb >> 9) & 1) << 5); R = (st >> 1) * 16 + swz / 64; C = (st & 1) * 32 + (swz % 64) / 2; }
__host__ __device__ __forceinline__ int perm32(int rho) { const int n = rho >> 4, i = rho & 15; return 8 * (i >> 2) + 4 * n + (i & 3); }

struct Unit { int pm, pn; };
struct Gemm { const bf16_t* A; const bf16_t* Bt; int M, N, K, lda, ldb, adiv; };

struct StaticOrder {
    int nM, nN, nwg, G, c;
    __device__ void init(int M, int N, int G_, int c_) { nM = M / BM; nN = N / BM; nwg = nM * nN; G = G_; c = c_; }
    __device__ bool next(int i, Unit& u) const {
        const long L = (long)i * G + c; if (L >= nwg) return false;
        int wgid = (int)L; { const int q = nwg / NXCD, r = nwg % NXCD, xcd = wgid % NXCD, off = wgid / NXCD; wgid = (xcd < r ? xcd * (q + 1) : r * (q + 1) + (xcd - r) * q) + off; }
        const int nig = WGM * nN, gid = wgid / nig, fm = gid * WGM, gsz = (nM - fm) < WGM ? (nM - fm) : WGM;
        u.pm = __builtin_amdgcn_readfirstlane(fm + ((wgid % nig) % gsz)); u.pn = __builtin_amdgcn_readfirstlane((wgid % nig) / gsz); return true;
    }
};

template <class Epi>
__device__ __forceinline__ void gemm_phase(LAS unsigned char* lds, const Gemm g, const StaticOrder& S, const Epi& E, const int tid) {
    const int wid = __builtin_amdgcn_readfirstlane(tid >> 6), lane = tid & 63, wr = wid >> 2, wc = wid & 3, fr = lane & 15, fq = lane >> 4;
    int K_ = g.K; asm volatile("" : "+s"(K_));
    const int K = K_, nt = K / BK;
    unsigned voffA[2], voffB[2];
#pragma unroll
    for (int i = 0; i < 2; ++i) { int R, C; stage_rc(tid * 16 + i * 8192, R, C); const int Rb = Epi::PERM ? ((R & ~31) + perm32(R & 31)) : R;
        voffA[i] = (unsigned)(R * g.lda + C) * 2u; voffB[i] = (unsigned)(Rb * g.ldb + C) * 2u; }
    const size_t kstep = (size_t)(BK * 2);
    const size_t hstepA = (size_t)HALF * g.lda * 2, hstepB = (size_t)HALF * g.ldb * 2;
    const size_t tstepA = 2 * hstepA, tstepB = 2 * hstepB;
    const unsigned ldsw = (unsigned)wid * 1024u;
    const int aoff = lds_byte(wr * 64 + fr, fq * 8), boff = lds_byte(wc * 32 + fr, fq * 8);
#define PG8_APTR(u) ((const char*)g.A + (size_t)(u).pm * tstepA + (g.adiv ? (size_t)((u).pn >> 1) * (size_t)K * 2 : (size_t)0))
#define PG8_BPTR(u) ((const char*)g.Bt + (size_t)(u).pn * tstepB)
#define PG8_SA(b, h) (((b) * 2 + (h)) * HTB)
#define PG8_SB(b, h) ((4 + (b) * 2 + (h)) * HTB)
#define PG8_STAGE(bufoff, gbase, voff) do { _Pragma("unroll") for (int _i = 0; _i < 2; ++_i) \
        __builtin_amdgcn_global_load_lds((const unsigned*)((const char*)(gbase) + (voff)[_i]), (LAS unsigned*)(lds + (bufoff) + ldsw + _i * 8192), 16, 0, 0); } while (0)
#define PG8_LDA(dst, b, h) do { _Pragma("unroll") for (int m = 0; m < 4; ++m) _Pragma("unroll") for (int k = 0; k < 2; ++k) dst[m][k] = *(const LAS bf16x8*)(lds + PG8_SA(b, h) + aoff + m * 2048 + k * 1024); } while (0)
#define PG8_LDB(dst, b, h) do { _Pragma("unroll") for (int n = 0; n < 2; ++n) _Pragma("unroll") for (int k = 0; k < 2; ++k) dst[n][k] = *(const LAS bf16x8*)(lds + PG8_SB(b, h) + boff + n * 2048 + k * 1024); } while (0)
#define PG8_MMA(ai, bj, At, Bt) do { __builtin_amdgcn_s_setprio(1); _Pragma("unroll") for (int m = 0; m < 4; ++m) _Pragma("unroll") for (int n = 0; n < 2; ++n) _Pragma("unroll") for (int k = 0; k < 2; ++k) \
        acc[ai][bj][m][n] = __builtin_amdgcn_mfma_f32_16x16x32_bf16(Bt[n][k], At[m][k], acc[ai][bj][m][n], 0, 0, 0); __builtin_amdgcn_s_setprio(0); } while (0)
#define PG8_WAIT_V(n) asm volatile("s_waitcnt vmcnt(" #n ")" ::: "memory")
#define PG8_WAIT_L(n) asm volatile("s_waitcnt lgkmcnt(" #n ")" ::: "memory")
#define PG8_BAR __builtin_amdgcn_s_barrier()
#define PG8_SCHED __builtin_amdgcn_sched_barrier(0)
    Unit cur, nxt; int ui = 0;
    if (!S.next(0, cur)) return;
    f32x4 acc[2][2][4][2];
#pragma unroll
    for (int a = 0; a < 2; ++a)
#pragma unroll
        for (int b = 0; b < 2; ++b)
#pragma unroll
            for (int m = 0; m < 4; ++m)
#pragma unroll
                for (int n = 0; n < 2; ++n) acc[a][b][m][n] = (f32x4){0.f, 0.f, 0.f, 0.f};
    bf16x8 At[4][2], B0[2][2], B1[2][2];
    const char* cA = PG8_APTR(cur); const char* cB = PG8_BPTR(cur);
    PG8_STAGE(PG8_SB(0, 0), cB, voffB); PG8_STAGE(PG8_SB(0, 1), cB + hstepB, voffB); PG8_STAGE(PG8_SA(0, 0), cA, voffA); PG8_STAGE(PG8_SA(0, 1), cA + hstepA, voffA);
    if (wr == 1) PG8_BAR;
    PG8_WAIT_V(2); PG8_BAR;
    PG8_STAGE(PG8_SB(1, 0), cB + kstep, voffB); PG8_STAGE(PG8_SA(1, 0), cA + kstep, voffA); PG8_STAGE(PG8_SB(1, 1), cB + hstepB + kstep, voffB);
    PG8_WAIT_V(6); PG8_BAR;
    for (;;) {
        const bool has_next = S.next(ui + 1, nxt);
        const char* nA = has_next ? PG8_APTR(nxt) : cA; const char* nB = has_next ? PG8_BPTR(nxt) : cB;
        for (int t = 0; t < nt; t += 2) {
            const bool last = (t == nt - 2);
            const char* a1 = cA + (size_t)(t + 1) * kstep;
            const char* a2 = last ? nA : cA + (size_t)(t + 2) * kstep; const char* b2 = last ? nB : cB + (size_t)(t + 2) * kstep;
            const char* a3 = a2 + kstep; const char* b3 = b2 + kstep;
            PG8_LDB(B0, 0, 0); PG8_LDB(B1, 0, 1); PG8_SCHED; PG8_LDA(At, 0, 0); PG8_STAGE(PG8_SA(1, 1), a1 + hstepA, voffA);
            PG8_WAIT_V(8); PG8_WAIT_L(0); PG8_BAR; PG8_MMA(0, 0, At, B0); PG8_MMA(0, 1, At, B1); PG8_BAR; PG8_SCHED;
            PG8_LDA(At, 0, 1); PG8_STAGE(PG8_SB(0, 0), b2, voffB); PG8_STAGE(PG8_SB(0, 1), b2 + hstepB, voffB); PG8_STAGE(PG8_SA(0, 0), a2, voffA);
            PG8_WAIT_V(8); PG8_WAIT_L(0); PG8_BAR; PG8_MMA(1, 0, At, B0); PG8_MMA(1, 1, At, B1); PG8_BAR; PG8_SCHED;
            PG8_LDB(B0, 1, 0); PG8_LDB(B1, 1, 1); PG8_SCHED; PG8_LDA(At, 1, 0); PG8_STAGE(PG8_SA(0, 1), a2 + hstepA, voffA);
            PG8_WAIT_V(8); PG8_WAIT_L(0); PG8_BAR; PG8_MMA(0, 0, At, B0); PG8_MMA(0, 1, At, B1); PG8_BAR; PG8_SCHED;
            PG8_LDA(At, 1, 1); PG8_STAGE(PG8_SB(1, 0), b3, voffB); PG8_STAGE(PG8_SB(1, 1), b3 + hstepB, voffB); PG8_STAGE(PG8_SA(1, 0), a3, voffA);
            PG8_WAIT_V(8); PG8_WAIT_L(0); PG8_BAR; PG8_MMA(1, 0, At, B0); PG8_MMA(1, 1, At, B1); PG8_BAR; PG8_SCHED;
        }
        if (wr == 0) PG8_BAR;
        E(acc, cur, wr, wc, fr, fq);
        if (!has_next) break;
#pragma unroll
        for (int a = 0; a < 2; ++a)
#pragma unroll
            for (int b = 0; b < 2; ++b)
#pragma unroll
                for (int m = 0; m < 4; ++m)
#pragma unroll
                    for (int n = 0; n < 2; ++n) acc[a][b][m][n] = (f32x4){0.f, 0.f, 0.f, 0.f};
        cur = nxt; cA = nA; cB = nB; ++ui;
        if (wr == 1) PG8_BAR;
    }
    PG8_WAIT_V(0);
    PG8_BAR;
#undef PG8_APTR
#undef PG8_BPTR
#undef PG8_SA
#undef PG8_SB
#undef PG8_STAGE
#undef PG8_LDA
#undef PG8_LDB
#undef PG8_MMA
#undef PG8_WAIT_V
#undef PG8_WAIT_L
#undef PG8_BAR
#undef PG8_SCHED
}
}
using pg8::Unit;

struct EpiXY {
    static constexpr bool PERM = true;
    bf16_t* XR; bf16_t* YG;
    __device__ __forceinline__ void operator()(const f32x4 (&acc)[2][2][4][2], const Unit& u, int wr, int wc, int fr, int fq) const {
        const int row0 = u.pm * 256 + wr * 64 + fr; const bool isg = (u.pn >> 2) & 1;
        bf16_t* base = isg ? YG : XR; const int col0 = ((u.pn & 3) + 4 * (u.pn >> 3)) * 256 + wc * 32 + 8 * fq;
#pragma unroll
        for (int ai = 0; ai < 2; ++ai)
#pragma unroll
            for (int m = 0; m < 4; ++m) { bf16_t* rowp = base + (size_t)(row0 + ai * 128 + m * 16) * D + col0;
#pragma unroll
                for (int bj = 0; bj < 2; ++bj) { f32x4 v0 = acc[ai][bj][m][0], v1 = acc[ai][bj][m][1];
                    if (isg) { v0 = gelu_tanh4(v0); v1 = gelu_tanh4(v1); }
                    u32x4 w; w.x = cvt_pk_bf16(v0[0], v0[1]); w.y = cvt_pk_bf16(v0[2], v0[3]); w.z = cvt_pk_bf16(v1[0], v1[1]); w.w = cvt_pk_bf16(v1[2], v1[3]);
                    *(u32x4*)(rowp + bj * 128) = w; } }
    }
};
struct EpiBf16 {
    static constexpr bool PERM = true;
    bf16_t* O; int ldc;
    __device__ __forceinline__ void operator()(const f32x4 (&acc)[2][2][4][2], const Unit& u, int wr, int wc, int fr, int fq) const {
        const int row0 = u.pm * 256 + wr * 64 + fr; const int col0 = u.pn * 256 + wc * 32 + 8 * fq;
#pragma unroll
        for (int ai = 0; ai < 2; ++ai)
#pragma unroll
            for (int m = 0; m < 4; ++m) { bf16_t* rowp = O + (size_t)(row0 + ai * 128 + m * 16) * ldc + col0;
#pragma unroll
                for (int bj = 0; bj < 2; ++bj) { const f32x4 v0 = acc[ai][bj][m][0], v1 = acc[ai][bj][m][1];
                    u32x4 w; w.x = cvt_pk_bf16(v0[0], v0[1]); w.y = cvt_pk_bf16(v0[2], v0[3]); w.z = cvt_pk_bf16(v1[0], v1[1]); w.w = cvt_pk_bf16(v1[2], v1[3]);
                    *(u32x4*)(rowp + bj * 128) = w; } }
    }
};
struct EpiGates {
    static constexpr bool PERM = false;
    const bf16_t* XRC; const float* br; const float* bi; const float* spt; bf16_t* DD; bf16_t* BB;
    __device__ __forceinline__ void operator()(const f32x4 (&acc)[2][2][4][2], const Unit& u, int wr, int wc, int fr, int fq) const {
        const int row0 = u.pm * 256 + wr * 64 + fr; const int chb = (u.pn >> 1) * 256 + (u.pn & 1) * 128 + wc * 32 + 4 * fq;
#pragma unroll
        for (int n = 0; n < 2; ++n) { const int ch = chb + 16 * n;
            const f32x4 br4 = *(const f32x4*)(br + ch), bi4 = *(const f32x4*)(bi + ch), sp4 = *(const f32x4*)(spt + ch);
            const bool slow = __ballot(fminf(fminf(sp4[0], sp4[1]), fminf(sp4[2], sp4[3])) <= -0.25f) != 0ull;
#pragma unroll
            for (int ai = 0; ai < 2; ++ai)
#pragma unroll
                for (int m = 0; m < 4; ++m) { const size_t off = (size_t)(row0 + ai * 128 + m * 16) * D + ch;
                    const u32x2 xw = *(const u32x2*)(XRC + off);
                    const float xr[4] = {bflo(xw.x), bfhi(xw.x), bflo(xw.y), bfhi(xw.y)};
                    f32x4 dv, bv;
#pragma unroll
                    for (int j = 0; j < 4; ++j) { float r, ig; sigmoid2(acc[ai][0][m][n][j] + br4[j], acc[ai][1][m][n][j] + bi4[j], r, ig);
                        const float la = r * sp4[j]; float dd = neg_expm1_small(la); if (slow) dd = la > -0.25f ? dd : 1.0f - __expf(la);
                        dv[j] = dd; bv[j] = __builtin_sqrtf(dd * (2.0f - dd)) * ig * xr[j]; }
                    u32x2 dw, bw; dw.x = cvt_pk_bf16(dv[0], dv[1]); dw.y = cvt_pk_bf16(dv[2], dv[3]); bw.x = cvt_pk_bf16(bv[0], bv[1]); bw.y = cvt_pk_bf16(bv[2], bv[3]);
                    *(u32x2*)(DD + off) = dw; *(u32x2*)(BB + off) = bw; asm volatile("" ::: "memory"); } }
    }
};
__device__ __forceinline__ void load_rstd(const ss_t* SS, int row0, float (&rs)[2][4]) {
#pragma unroll
    for (int ai = 0; ai < 2; ++ai)
#pragma unroll
        for (int m = 0; m < 4; ++m) rs[ai][m] = ss_rstd(SS + row0 + ai * 128 + m * 16);
}
template <bool XF32>
struct EpiResid {
    static constexpr bool PERM = true;
    const void* base; bf16_t* HB; ss_t* SS;
    __device__ __forceinline__ void operator()(const f32x4 (&acc)[2][2][4][2], const Unit& u, int wr, int wc, int fr, int fq) const {
        const int row0 = u.pm * 256 + wr * 64 + fr, col0 = u.pn * 256 + wc * 32 + 8 * fq;
#pragma unroll
        for (int ai = 0; ai < 2; ++ai)
#pragma unroll
            for (int m = 0; m < 4; ++m) { const int row = row0 + ai * 128 + m * 16; const size_t off = (size_t)row * D + col0; float sq = 0.f;
#pragma unroll
                for (int bj = 0; bj < 2; ++bj) { const size_t o = off + bj * 128; f32x4 b0, b1;
                    if (XF32) { b0 = *(const f32x4*)((const float*)base + o); b1 = *(const f32x4*)((const float*)base + o + 4); }
                    else { const u32x4 hw = *(const u32x4*)((const bf16_t*)base + o); b0 = (f32x4){bflo(hw.x), bfhi(hw.x), bflo(hw.y), bfhi(hw.y)}; b1 = (f32x4){bflo(hw.z), bfhi(hw.z), bflo(hw.w), bfhi(hw.w)}; }
                    const f32x4 r0 = b0 + acc[ai][bj][m][0], r1 = b1 + acc[ai][bj][m][1];
                    u32x4 hb; hb.x = cvt_pk_bf16(r0[0], r0[1]); hb.y = cvt_pk_bf16(r0[2], r0[3]); hb.z = cvt_pk_bf16(r1[0], r1[1]); hb.w = cvt_pk_bf16(r1[2], r1[3]); *(u32x4*)(HB + o) = hb;
                    sq += ((r0[0] * r0[0] + r0[1] * r0[1]) + (r0[2] * r0[2] + r0[3] * r0[3])) + ((r1[0] * r1[0] + r1[1] * r1[1]) + (r1[2] * r1[2] + r1[3] * r1[3])); }
                sq += __shfl_xor(sq, 16); sq += __shfl_xor(sq, 32);
                if (fq == 0) ss_add(SS + row, sq);
                if (m & 1) asm volatile("" ::: "memory"); }
    }
};
struct EpiSwiGLU {
    static constexpr bool PERM = true;
    bf16_t* ACT; const ss_t* SS;
    __device__ __forceinline__ void operator()(const f32x4 (&acc)[2][2][4][2], const Unit& u, int wr, int wc, int fr, int fq) const {
        const int row0 = u.pm * 256 + wr * 64 + fr, col0 = u.pn * 128 + wc * 32 + 8 * fq;
        float rs[2][4]; load_rstd(SS, row0, rs);
#pragma unroll
        for (int ai = 0; ai < 2; ++ai)
#pragma unroll
            for (int m = 0; m < 4; ++m) { const float r = rs[ai][m];
                const f32x4 g0 = acc[ai][0][m][0] * r, g1 = acc[ai][0][m][1] * r, u0 = acc[ai][1][m][0] * r, u1 = acc[ai][1][m][1] * r;
                const f32x4 v0 = g0 * sigmoid4(g0) * u0, v1 = g1 * sigmoid4(g1) * u1;
                u32x4 w; w.x = cvt_pk_bf16(v0[0], v0[1]); w.y = cvt_pk_bf16(v0[2], v0[3]); w.z = cvt_pk_bf16(v1[0], v1[1]); w.w = cvt_pk_bf16(v1[2], v1[3]);
                *(u32x4*)(ACT + (size_t)(row0 + ai * 128 + m * 16) * DFF + col0) = w; }
    }
};
struct EpiPP4 {
    static constexpr bool PERM = false;
    bf16_t* PP;
    __device__ __forceinline__ void operator()(const f32x4 (&acc)[2][2][4][2], const Unit& u, int wr, int wc, int fr, int fq) const {
        const int row0 = u.pm * 256 + wr * 64 + fr, col0 = u.pn * 256 + wc * 32 + 4 * fq;
#pragma unroll
        for (int ai = 0; ai < 2; ++ai)
#pragma unroll
            for (int m = 0; m < 4; ++m) { const size_t off = (size_t)(row0 + ai * 128 + m * 16) * D + col0;
#pragma unroll
                for (int bj = 0; bj < 2; ++bj)
#pragma unroll
                    for (int n = 0; n < 2; ++n) { const f32x4 v = acc[ai][bj][m][n]; u32x2 w; w.x = cvt_pk_bf16(v[0], v[1]); w.y = cvt_pk_bf16(v[2], v[3]); *(u32x2*)(PP + off + bj * 128 + n * 16) = w; } }
    }
};
template <bool EMIT>
struct EpiPle {
    static constexpr bool PERM = false;
    const bf16_t* HBi; const bf16_t* PP; const ss_t* SSi; bf16_t* HBo; ss_t* SSo;
    __device__ __forceinline__ void operator()(const f32x4 (&acc)[2][2][4][2], const Unit& u, int wr, int wc, int fr, int fq) const {
        const int row0 = u.pm * 256 + wr * 64 + fr, col0 = u.pn * 256 + wc * 32 + 4 * fq;
#pragma unroll
        for (int ai = 0; ai < 2; ++ai)
#pragma unroll
            for (int m = 0; m < 4; ++m) { const int row = row0 + ai * 128 + m * 16; const size_t off = (size_t)row * D + col0; const float rr = ss_rstd(SSi + row); float sq = 0.f;
#pragma unroll
                for (int bj = 0; bj < 2; ++bj)
#pragma unroll
                    for (int n = 0; n < 2; ++n) { const size_t o = off + bj * 128 + n * 16; const u32x2 hw = *(const u32x2*)(HBi + o); const u32x2 pw = *(const u32x2*)(PP + o);
                        const f32x4 a = acc[ai][bj][m][n]; f32x4 r;
                        r[0] = bflo(hw.x) + fsigmoid(rr * a[0]) * bflo(pw.x); r[1] = bfhi(hw.x) + fsigmoid(rr * a[1]) * bfhi(pw.x); r[2] = bflo(hw.y) + fsigmoid(rr * a[2]) * bflo(pw.y); r[3] = bfhi(hw.y) + fsigmoid(rr * a[3]) * bfhi(pw.y);
                        u32x2 hb; hb.x = cvt_pk_bf16(r[0], r[1]); hb.y = cvt_pk_bf16(r[2], r[3]); *(u32x2*)(HBo + o) = hb;
                        if (EMIT) sq += (r[0] * r[0] + r[1] * r[1]) + (r[2] * r[2] + r[3] * r[3]); }
                if (EMIT) { sq += __shfl_xor(sq, 16); sq += __shfl_xor(sq, 32); if (fq == 0) ss_add(SSo + row, sq); }
                asm volatile("" ::: "memory"); }
    }
};
struct EpiPleFinal {
    static constexpr bool PERM = false;
    const bf16_t* HBi; const bf16_t* PP; const ss_t* SSi; ss_t* SSo; unsigned* cnt; const float* gfin; float* out;
    __device__ __forceinline__ void operator()(const f32x4 (&acc_)[2][2][4][2], const Unit& u, int wr, int wc, int fr, int fq) const {
        f32x4 (&acc)[2][2][4][2] = const_cast<f32x4 (&)[2][2][4][2]>(acc_);
        const int row0 = u.pm * 256 + wr * 64 + fr, col0 = u.pn * 256 + wc * 32 + 4 * fq;
#pragma unroll
        for (int ai = 0; ai < 2; ++ai)
#pragma unroll
            for (int m = 0; m < 4; ++m) { const int row = row0 + ai * 128 + m * 16; const size_t off = (size_t)row * D + col0; const float rr = ss_rstd(SSi + row); float sq = 0.f;
#pragma unroll
                for (int bj = 0; bj < 2; ++bj)
#pragma unroll
                    for (int n = 0; n < 2; ++n) { const size_t o = off + bj * 128 + n * 16; const u32x2 hw = *(const u32x2*)(HBi + o); const u32x2 pw = *(const u32x2*)(PP + o);
                        const f32x4 a = acc[ai][bj][m][n]; f32x4 r;
                        r[0] = bflo(hw.x) + fsigmoid(rr * a[0]) * bflo(pw.x); r[1] = bfhi(hw.x) + fsigmoid(rr * a[1]) * bfhi(pw.x); r[2] = bflo(hw.y) + fsigmoid(rr * a[2]) * bflo(pw.y); r[3] = bfhi(hw.y) + fsigmoid(rr * a[3]) * bfhi(pw.y);
                        acc[ai][bj][m][n] = r; sq += (r[0] * r[0] + r[1] * r[1]) + (r[2] * r[2] + r[3] * r[3]); }
                sq += __shfl_xor(sq, 16); sq += __shfl_xor(sq, 32); if (fq == 0) ss_add(SSo + row, sq);
                asm volatile("" ::: "memory"); }
        asm volatile("s_waitcnt vmcnt(0)" ::: "memory");
        unsigned* pc = cnt + 64 * u.pm;
        if (fr == 0 && fq == 0) (void)__hip_atomic_fetch_add(pc, 1u, __ATOMIC_RELAXED, __HIP_MEMORY_SCOPE_AGENT);
        { unsigned spins = 0; while ((unsigned)__builtin_amdgcn_readfirstlane((int)__hip_atomic_load(pc, __ATOMIC_RELAXED, __HIP_MEMORY_SCOPE_AGENT)) < 64u) { __builtin_amdgcn_s_sleep(2); if (++spins > (1u << 20)) break; } }
        asm volatile("" ::: "memory");
#pragma unroll
        for (int ai = 0; ai < 2; ++ai)
#pragma unroll
            for (int m = 0; m < 4; ++m) { const int row = row0 + ai * 128 + m * 16; const size_t off = (size_t)row * D + col0;
                const ss_t tot = __hip_atomic_load(SSo + row, __ATOMIC_RELAXED, __HIP_MEMORY_SCOPE_AGENT); const float rs = rsqrtf((float)tot * (1.0f / (1048576.0f * 2048.0f)) + 1e-6f);
#pragma unroll
                for (int bj = 0; bj < 2; ++bj)
#pragma unroll
                    for (int n = 0; n < 2; ++n) { const int c = bj * 128 + n * 16; const f32x4 g4 = *(const f32x4*)(gfin + col0 + c); *(f32x4*)(out + off + c) = acc[ai][bj][m][n] * rs * g4; } }
    }
};
struct EpiSsdIn {
    static constexpr bool PERM = true;
    bf16_t* Z; bf16_t* XB; const ss_t* SS;
    __device__ __forceinline__ void operator()(const f32x4 (&acc)[2][2][4][2], const Unit& u, int wr, int wc, int fr, int fq) const {
        const int row0 = u.pm * 256 + wr * 64 + fr;
        const bool isz = u.pn < 16; bf16_t* base = isz ? Z : XB; const int ldc = isz ? SSD_INNER : SSD_CONV; const int col0 = (isz ? u.pn : u.pn - 16) * 256 + wc * 32 + 8 * fq;
#pragma unroll
        for (int ai = 0; ai < 2; ++ai)
#pragma unroll
            for (int m = 0; m < 4; ++m) { bf16_t* rowp = base + (size_t)(row0 + ai * 128 + m * 16) * ldc + col0; const float rr = ss_rstd(SS + row0 + ai * 128 + m * 16);
#pragma unroll
                for (int bj = 0; bj < 2; ++bj) { const f32x4 v0 = acc[ai][bj][m][0] * rr, v1 = acc[ai][bj][m][1] * rr;
                    u32x4 w; w.x = cvt_pk_bf16(v0[0], v0[1]); w.y = cvt_pk_bf16(v0[2], v0[3]); w.z = cvt_pk_bf16(v1[0], v1[1]); w.w = cvt_pk_bf16(v1[2], v1[3]);
                    *(u32x4*)(rowp + bj * 128) = w; } }
    }
};
struct EpiDtPart {
    static constexpr bool PERM = true;
    float* DTP;
    __device__ __forceinline__ void operator()(const f32x4 (&acc)[2][2][4][2], const Unit& u, int wr, int wc, int fr, int fq) const {
        const int row0 = u.pm * 256 + wr * 64 + fr;
        if (wc < 2) { const int col0 = wc * 32 + 8 * fq;
#pragma unroll
            for (int ai = 0; ai < 2; ++ai)
#pragma unroll
                for (int m = 0; m < 4; ++m) { float* rowp = DTP + (size_t)(row0 + ai * 128 + m * 16) * SSD_H + col0; *(f32x4*)rowp = acc[ai][0][m][0]; *(f32x4*)(rowp + 4) = acc[ai][0][m][1]; } }
    }
};

__device__ __forceinline__ void xpose_item(const float* src, int ld, bf16_t* dst, int K, int k0, LAS float* scr, int lane, const float* gk, bool nts) {
    if (src) {
#pragma unroll 8
        for (int i = 0; i < 32; ++i) { const int kk = 2 * i + (lane >> 5); scr[kk * 33 + (lane & 31)] = __builtin_nontemporal_load(src + (size_t)(k0 + kk) * ld + (lane & 31)); }
    } else {
#pragma unroll 8
        for (int i = 0; i < 32; ++i) { const int kk = 2 * i + (lane >> 5); scr[kk * 33 + (lane & 31)] = 0.f; }
    }
    const int c = lane & 7;
    f32x4 g0 = (f32x4){1.f, 1.f, 1.f, 1.f}, g1 = g0;
    if (gk) { g0 = *(const f32x4*)(gk + k0 + 8 * c); g1 = *(const f32x4*)(gk + k0 + 8 * c + 4); }
    asm volatile("s_waitcnt lgkmcnt(0)" ::: "memory");
#pragma unroll
    for (int j = 0; j < 4; ++j) { const int n = (lane >> 3) + 8 * j; const LAS float* s = scr + (8 * c) * 33 + n;
        u32x4 o; o.x = cvt_pk_bf16(s[0 * 33] * g0[0], s[1 * 33] * g0[1]); o.y = cvt_pk_bf16(s[2 * 33] * g0[2], s[3 * 33] * g0[3]); o.z = cvt_pk_bf16(s[4 * 33] * g1[0], s[5 * 33] * g1[1]); o.w = cvt_pk_bf16(s[6 * 33] * g1[2], s[7 * 33] * g1[3]);
        if (nts) __builtin_nontemporal_store(o, (u32x4*)(dst + (size_t)n * K + k0 + 8 * c)); else *(u32x4*)(dst + (size_t)n * K + k0 + 8 * c) = o; }
    asm volatile("s_waitcnt lgkmcnt(0)" ::: "memory");
}
__device__ __forceinline__ int xpose_all(const float* src, const float* src2, int ld, int K, int ndst, int nsrc, int mode, bf16_t* dst, int it, int NGW, LAS float* scr, int lane, const float* gvec = nullptr, bool nts = false) {
    const int nblk = ndst / 32, nitems = (K / 64) * nblk;
    for (; it < nitems; it += NGW) {
        const int kb = it / nblk, nb = it % nblk, n0 = nb * 32; const float* sp;
        if (mode == 0) sp = (n0 < nsrc) ? src + n0 : nullptr;
        else if (mode == 1) { const int unit = n0 >> 8, bj = (n0 >> 7) & 1, cl = n0 & 127; sp = (bj ? src2 : src) + unit * 128 + cl; }
        else if (mode == 3) { const int pn = n0 >> 8, cl = n0 & 255; sp = src + ((pn >> 2) & 1) * 2048 + ((pn & 3) + 4 * (pn >> 3)) * 256 + cl; }
        else { const int unit = n0 >> 8, bj = (n0 >> 7) & 1, cl = n0 & 127; sp = (bj ? src2 : src) + (size_t)(unit >> 1) * 65536 + (unit & 1) * 128 + cl; }
        xpose_item(sp, ld, dst + (size_t)n0 * K, K, kb * 64, scr, lane, gvec, nts);
    }
    return it - nitems;
}
__device__ __forceinline__ void rms_row(const float* xrow, const float* g, bf16_t* orow, int lane) {
    const f32x4* xr = (const f32x4*)xrow + lane; f32x4 v[8]; float s = 0.f;
#pragma unroll
    for (int j = 0; j < 8; ++j) { v[j] = xr[64 * j]; s += (v[j][0] * v[j][0] + v[j][1] * v[j][1]) + (v[j][2] * v[j][2] + v[j][3] * v[j][3]); }
    const float rstd = rsqrtf(wave_sum(s) * (1.f / D) + EPS);
    const f32x4* gr = (const f32x4*)g + lane;
#pragma unroll
    for (int j = 0; j < 8; ++j) { const f32x4 gv = gr[64 * j]; const f32x4 o = v[j] * rstd * gv; u32x2 w; w.x = cvt_pk_bf16(o[0], o[1]); w.y = cvt_pk_bf16(o[2], o[3]); ((u32x2*)orow)[lane + 64 * j] = w; }
}
__device__ __forceinline__ void rms_phase(const float* X, const float* g, bf16_t* O, int gw, int NGW, int lane) {
    for (int m = gw; m < T; m += NGW) rms_row(X + (size_t)m * D, g, O + (size_t)m * D, lane);
}
__device__ __forceinline__ void final_norm_phase(const bf16_t* HB, const float* g, float* out, int gw, int NGW, int lane) {
    for (int m = gw; m < T; m += NGW) {
        const u32x4* hr = (const u32x4*)(HB + (size_t)m * D) + lane; float f[4][8]; float s = 0.f;
#pragma unroll
        for (int j = 0; j < 4; ++j) { const u32x4 v = hr[64 * j]; f[j][0] = bflo(v.x); f[j][1] = bfhi(v.x); f[j][2] = bflo(v.y); f[j][3] = bfhi(v.y); f[j][4] = bflo(v.z); f[j][5] = bfhi(v.z); f[j][6] = bflo(v.w); f[j][7] = bfhi(v.w);
#pragma unroll
            for (int e = 0; e < 8; ++e) s += f[j][e] * f[j][e]; }
        const float rstd = rsqrtf(wave_sum(s) * (1.f / D) + EPS);
        float* orow = out + (size_t)m * D;
#pragma unroll
        for (int j = 0; j < 4; ++j) { const int c0 = 8 * lane + 512 * j; const f32x4 g0 = *(const f32x4*)(g + c0), g1 = *(const f32x4*)(g + c0 + 4);
            *(f32x4*)(orow + c0) = (f32x4){f[j][0] * rstd * g0[0], f[j][1] * rstd * g0[1], f[j][2] * rstd * g0[2], f[j][3] * rstd * g0[3]};
            *(f32x4*)(orow + c0 + 4) = (f32x4){f[j][4] * rstd * g1[0], f[j][5] * rstd * g1[1], f[j][6] * rstd * g1[2], f[j][7] * rstd * g1[3]}; }
    }
}
template <bool SILU>
__device__ __forceinline__ void conv_phase(const bf16_t* src, const float* w, const float* b, bf16_t* dst, int C, int gt, int NGT) {
    const int c8n = C / 8; const int nitems = (T / 16) * c8n;
    for (int it = gt; it < nitems; it += NGT) {
        const int rb = it / c8n, c0 = (it % c8n) * 8, row0 = rb * 16;
        float wt[4][8], bs[8];
#pragma unroll
        for (int k = 0; k < 4; ++k) { const f32x4 w0 = *(const f32x4*)(w + (size_t)k * C + c0), w1 = *(const f32x4*)(w + (size_t)k * C + c0 + 4);
            wt[k][0] = w0[0]; wt[k][1] = w0[1]; wt[k][2] = w0[2]; wt[k][3] = w0[3]; wt[k][4] = w1[0]; wt[k][5] = w1[1]; wt[k][6] = w1[2]; wt[k][7] = w1[3]; }
        { const f32x4 b0 = *(const f32x4*)(b + c0), b1 = *(const f32x4*)(b + c0 + 4); bs[0] = b0[0]; bs[1] = b0[1]; bs[2] = b0[2]; bs[3] = b0[3]; bs[4] = b1[0]; bs[5] = b1[1]; bs[6] = b1[2]; bs[7] = b1[3]; }
        const bool head = (row0 & (SEQ - 1)) == 0;
        const bf16_t* sp = src + (size_t)row0 * C + c0;
        u32x4 x0, x1, x2;
        if (head) { x0 = (u32x4){0u, 0u, 0u, 0u}; x1 = x0; x2 = x0; }
        else { x0 = *(const u32x4*)(sp - (size_t)3 * C); x1 = *(const u32x4*)(sp - (size_t)2 * C); x2 = *(const u32x4*)(sp - (size_t)C); }
#pragma unroll 4
        for (int r = 0; r < 16; ++r) {
            const u32x4 x3 = *(const u32x4*)(sp + (size_t)r * C);
            const unsigned xa[4][4] = {{x0.x, x0.y, x0.z, x0.w}, {x1.x, x1.y, x1.z, x1.w}, {x2.x, x2.y, x2.z, x2.w}, {x3.x, x3.y, x3.z, x3.w}};
            float a[8];
#pragma unroll
            for (int j = 0; j < 8; ++j) a[j] = bs[j];
#pragma unroll
            for (int k = 0; k < 4; ++k)
#pragma unroll
                for (int q = 0; q < 4; ++q) { a[2 * q] += wt[k][2 * q] * bflo(xa[k][q]); a[2 * q + 1] += wt[k][2 * q + 1] * bfhi(xa[k][q]); }
            if (SILU) {
#pragma unroll
                for (int j = 0; j < 8; ++j) a[j] = fsilu(a[j]); }
            u32x4 o; o.x = cvt_pk_bf16(a[0], a[1]); o.y = cvt_pk_bf16(a[2], a[3]); o.z = cvt_pk_bf16(a[4], a[5]); o.w = cvt_pk_bf16(a[6], a[7]);
            *(u32x4*)(dst + (size_t)(row0 + r) * C + c0) = o;
            x0 = x1; x1 = x2; x2 = x3;
        }
    }
}
__device__ __forceinline__ void lru_scan_phase(const bf16_t* DD, const bf16_t* BB, const bf16_t* YG, bf16_t* Y, LAS float* sm, int tid, int bid, int G) {
    const int cq = tid & 7, sub = tid >> 3;
    LAS f32x4* sP = (LAS f32x4*)sm; LAS f32x4* sH = sP + 512;
    for (int w = bid; w < 256; w += G) {
        const int b = w >> 6, ch = (w & 63) * 32 + cq * 4; const size_t base = ((size_t)b * SEQ + (size_t)sub * 32) * D + ch;
        f32x4 P = (f32x4){1.f, 1.f, 1.f, 1.f}, Hh = (f32x4){0.f, 0.f, 0.f, 0.f};
#pragma unroll 8
        for (int t = 0; t < 32; ++t) { const u32x2 dw = *(const u32x2*)(DD + base + (size_t)t * D), bw = *(const u32x2*)(BB + base + (size_t)t * D);
            const f32x4 a = (f32x4){1.f - bflo(dw.x), 1.f - bfhi(dw.x), 1.f - bflo(dw.y), 1.f - bfhi(dw.y)}, bv = (f32x4){bflo(bw.x), bfhi(bw.x), bflo(bw.y), bfhi(bw.y)}; Hh = a * Hh + bv; P = P * a; }
        sP[tid] = P; sH[tid] = Hh;
        __syncthreads();
        f32x4 h = (f32x4){0.f, 0.f, 0.f, 0.f};
        for (int k = 0; k < sub; ++k) h = sP[k * 8 + cq] * h + sH[k * 8 + cq];
#pragma unroll 8
        for (int t = 0; t < 32; ++t) { const u32x2 dw = *(const u32x2*)(DD + base + (size_t)t * D), bw = *(const u32x2*)(BB + base + (size_t)t * D); const u32x2 yg = *(const u32x2*)(YG + base + (size_t)t * D);
            const f32x4 a = (f32x4){1.f - bflo(dw.x), 1.f - bfhi(dw.x), 1.f - bflo(dw.y), 1.f - bfhi(dw.y)}, bv = (f32x4){bflo(bw.x), bfhi(bw.x), bflo(bw.y), bfhi(bw.y)};
            h = a * h + bv; u32x2 o; o.x = cvt_pk_bf16(h[0] * bflo(yg.x), h[1] * bfhi(yg.x)); o.y = cvt_pk_bf16(h[2] * bflo(yg.y), h[3] * bfhi(yg.y)); *(u32x2*)(Y + base + (size_t)t * D) = o; }
        __syncthreads();
    }
}
constexpr int SS_RS = 136;
constexpr int SS_CT = 0, SS_BT = 34816, SS_XT = 69632, SS_XW = 87040, SS_SIN = 104448, SS_CS = 121856, SS_DTV = 122368;
__device__ __forceinline__ void ssd_phase(const bf16_t* XBC, const float* DT  , const ss_t* SSq, const float* dtb, const bf16_t* Z, const float* a_log, const float* d_skip, bf16_t* YS, LAS unsigned char* lds, int tid, int wid, int lane, int bid, int G) {
    const int fr = lane & 15, fq = lane >> 4;
    LAS bf16_t* Ct = (LAS bf16_t*)(lds + SS_CT); LAS bf16_t* Bt = (LAS bf16_t*)(lds + SS_BT); LAS bf16_t* XT = (LAS bf16_t*)(lds + SS_XT); LAS bf16_t* XW = (LAS bf16_t*)(lds + SS_XW);
    LAS bf16_t* Sin = (LAS bf16_t*)(lds + SS_SIN); LAS float* csv = (LAS float*)(lds + SS_CS); LAS float* dtv = (LAS float*)(lds + SS_DTV);
    for (int w = bid; w < 256; w += G) {
        const int b = w >> 6, h = w & 63, g = h >> 3;
        const float A = -expf(a_log[h]), Dh = d_skip[h], dtbh = dtb[h];
        f32x4 Sacc[4];
#pragma unroll
        for (int pt = 0; pt < 4; ++pt) Sacc[pt] = (f32x4){0.f, 0.f, 0.f, 0.f};
        u32x4 cr[4], br[4], xr2[2]; float d0 = 0.f, d1 = 0.f;
        const unsigned voffC = (unsigned)(((tid >> 4) * SSD_CONV + 5120 + g * 128 + (tid & 15) * 8) * 2), voffX = (unsigned)(((tid & 127) * SSD_CONV + h * 64 + (tid >> 7) * 8) * 2);
#define SSD_GLOADS(cc) do { const size_t r0_ = (size_t)b * SEQ + (size_t)(cc) * 128; const char* xr_ = (const char*)(XBC + r0_ * SSD_CONV); \
            _Pragma("unroll") for (int k = 0; k < 4; ++k) { const char* kb_ = xr_ + (size_t)k * (32 * SSD_CONV * 2); \
                cr[k] = *(const u32x4*)(kb_ + voffC); br[k] = *(const u32x4*)(kb_ + voffC - 2048); } \
            _Pragma("unroll") for (int k = 0; k < 2; ++k) xr2[k] = *(const u32x4*)(xr_ + voffX + k * 64); \
            if (wid == 0) { const size_t i0_ = (r0_ + 2 * lane) * SSD_H + h; float s0_ = 0.f, s1_ = 0.f; \
                _Pragma("unroll") for (int q = 0; q < 8; ++q) { s0_ += DT[(size_t)q * T * SSD_H + i0_]; s1_ += DT[(size_t)q * T * SSD_H + i0_ + SSD_H]; } \
                d0 = fsoftplus(ss_rstd(SSq + r0_ + 2 * lane) * s0_ + dtbh); d1 = fsoftplus(ss_rstd(SSq + r0_ + 2 * lane + 1) * s1_ + dtbh); } } while (0)
        SSD_GLOADS(0);
        for (int c = 0; c < 16; ++c) {
            const size_t row0 = (size_t)b * SEQ + (size_t)c * 128;
            __syncthreads();
            if (wid == 0) {
                const int l0 = 2 * lane;
                const float a0 = A * d0, a1 = A * d1; float incl = a0 + a1;
#pragma unroll
                for (int o = 1; o < 64; o <<= 1) { const float tv = __shfl_up(incl, o); if (lane >= o) incl += tv; }
                csv[l0 + 1] = incl; csv[l0] = incl - a1; dtv[l0] = d0; dtv[l0 + 1] = d1;
            }
#pragma unroll
            for (int pt = 0; pt < 4; ++pt) { u32x2 wv; wv.x = cvt_pk_bf16(Sacc[pt][0], Sacc[pt][1]); wv.y = cvt_pk_bf16(Sacc[pt][2], Sacc[pt][3]);
                *(LAS u32x2*)(Sin + (16 * pt + fr) * SS_RS + 16 * wid + 4 * fq) = wv; }
#pragma unroll
            for (int k = 0; k < 4; ++k) { const int it = tid + 512 * k, r = it >> 4, c16 = it & 15;
                *(LAS u32x4*)(Ct + r * SS_RS + c16 * 8) = cr[k]; *(LAS u32x4*)(Bt + r * SS_RS + c16 * 8) = br[k]; }
            __syncthreads();
            const float total = csv[127];
#pragma unroll
            for (int k = 0; k < 2; ++k) { const int it = tid + 512 * k, sx = it & 127, oct = it >> 7; const float dts = dtv[sx], dtw = dts * __expf(total - csv[sx]);
                const unsigned xw[4] = {xr2[k].x, xr2[k].y, xr2[k].z, xr2[k].w};
#pragma unroll
                for (int j = 0; j < 4; ++j) { const float x0 = bflo(xw[j]), x1 = bfhi(xw[j]);
                    const unsigned pa = cvt_pk_bf16(x0 * dts, x1 * dts), pb = cvt_pk_bf16(x0 * dtw, x1 * dtw);
                    XT[(oct * 8 + 2 * j) * SS_RS + sx] = (bf16_t)(pa & 0xffffu); XT[(oct * 8 + 2 * j + 1) * SS_RS + sx] = (bf16_t)(pa >> 16);
                    XW[(oct * 8 + 2 * j) * SS_RS + sx] = (bf16_t)(pb & 0xffffu); XW[(oct * 8 + 2 * j + 1) * SS_RS + sx] = (bf16_t)(pb >> 16); } }
            __syncthreads();
            if (c + 1 < 16) SSD_GLOADS(c + 1);
            const int lrow = 16 * wid + fr; const float csl = csv[lrow];

            bf16x8 Cfr[4];
#pragma unroll
            for (int ks = 0; ks < 4; ++ks) Cfr[ks] = *(const LAS bf16x8*)(Ct + lrow * SS_RS + 32 * ks + 8 * fq);
            unsigned gp[8][2];
#pragma unroll
            for (int t = 0; t < 8; ++t) {
                if (t <= wid) {
                    f32x4 acc = (f32x4){0.f, 0.f, 0.f, 0.f};
#pragma unroll
                    for (int ks = 0; ks < 4; ++ks) { const bf16x8 bfr = *(const LAS bf16x8*)(Bt + (16 * t + fr) * SS_RS + 32 * ks + 8 * fq); acc = __builtin_amdgcn_mfma_f32_16x16x32_bf16(bfr, Cfr[ks], acc, 0, 0, 0); }
                    const f32x4 cs4 = *(const LAS f32x4*)(csv + 16 * t + 4 * fq); float v[4];
#pragma unroll
                    for (int r = 0; r < 4; ++r) { const int sx = 16 * t + 4 * fq + r; v[r] = (sx <= lrow) ? acc[r] * __expf(csl - cs4[r]) : 0.f; }
                    gp[t][0] = cvt_pk_bf16(v[0], v[1]); gp[t][1] = cvt_pk_bf16(v[2], v[3]);
                } else { gp[t][0] = 0u; gp[t][1] = 0u; }
                __builtin_amdgcn_sched_barrier(0);
            }
            f32x4 accd[4], acco[4];
#pragma unroll
            for (int pt = 0; pt < 4; ++pt) { accd[pt] = (f32x4){0.f, 0.f, 0.f, 0.f}; acco[pt] = (f32x4){0.f, 0.f, 0.f, 0.f}; }
#pragma unroll
            for (int u = 0; u < 4; ++u) {
                if (2 * u <= wid) {
                    u32x4 gq; gq.x = gp[2 * u][0]; gq.y = gp[2 * u][1]; gq.z = gp[2 * u + 1][0]; gq.w = gp[2 * u + 1][1];
                    const bf16x8 gfr = __builtin_bit_cast(bf16x8, gq);
#pragma unroll
                    for (int pt = 0; pt < 4; ++pt) { const u32x2 lo = *(const LAS u32x2*)(XT + (16 * pt + fr) * SS_RS + 32 * u + 4 * fq), hi = *(const LAS u32x2*)(XT + (16 * pt + fr) * SS_RS + 32 * u + 16 + 4 * fq);
                        u32x4 xq; xq.x = lo.x; xq.y = lo.y; xq.z = hi.x; xq.w = hi.y;
                        accd[pt] = __builtin_amdgcn_mfma_f32_16x16x32_bf16(__builtin_bit_cast(bf16x8, xq), gfr, accd[pt], 0, 0, 0); }
                }
                __builtin_amdgcn_sched_barrier(0);
            }
#pragma unroll
            for (int ks = 0; ks < 4; ++ks) {
#pragma unroll
                for (int pt = 0; pt < 4; ++pt) { const bf16x8 sfr = *(const LAS bf16x8*)(Sin + (16 * pt + fr) * SS_RS + 32 * ks + 8 * fq); acco[pt] = __builtin_amdgcn_mfma_f32_16x16x32_bf16(sfr, Cfr[ks], acco[pt], 0, 0, 0); }
                __builtin_amdgcn_sched_barrier(0); }
            {
                const float el = __expf(csl); const size_t grow = row0 + lrow;
#pragma unroll
                for (int pt = 0; pt < 4; ++pt) { const int pc = h * 64 + 16 * pt + 4 * fq;
                    const u32x2 xv = *(const u32x2*)(XBC + grow * SSD_CONV + pc), zv = *(const u32x2*)(Z + grow * SSD_INNER + pc);
                    const float xs[4] = {bflo(xv.x), bfhi(xv.x), bflo(xv.y), bfhi(xv.y)}, zs[4] = {bflo(zv.x), bfhi(zv.x), bflo(zv.y), bfhi(zv.y)}; float y[4];
#pragma unroll
                    for (int r = 0; r < 4; ++r) y[r] = (accd[pt][r] + el * acco[pt][r] + Dh * xs[r]) * fsilu(zs[r]);
                    u32x2 o; o.x = cvt_pk_bf16(y[0], y[1]); o.y = cvt_pk_bf16(y[2], y[3]); *(u32x2*)(YS + grow * SSD_INNER + pc) = o; }
            }
            {
                const float eT = __expf(total);
#pragma unroll
                for (int pt = 0; pt < 4; ++pt) Sacc[pt] = Sacc[pt] * eT;
#pragma unroll
                for (int u = 0; u < 4; ++u) { unsigned short bs[8];
#pragma unroll
                    for (int e = 0; e < 8; ++e) bs[e] = Bt[(32 * u + 8 * fq + e) * SS_RS + 16 * wid + fr];
                    u32x4 bq; bq.x = (unsigned)bs[0] | ((unsigned)bs[1] << 16); bq.y = (unsigned)bs[2] | ((unsigned)bs[3] << 16); bq.z = (unsigned)bs[4] | ((unsigned)bs[5] << 16); bq.w = (unsigned)bs[6] | ((unsigned)bs[7] << 16);
                    const bf16x8 pfr = __builtin_bit_cast(bf16x8, bq);
#pragma unroll
                    for (int pt = 0; pt < 4; ++pt) { const bf16x8 qfr = *(const LAS bf16x8*)(XW + (16 * pt + fr) * SS_RS + 32 * u + 8 * fq); Sacc[pt] = __builtin_amdgcn_mfma_f32_16x16x32_bf16(pfr, qfr, Sacc[pt], 0, 0, 0); }
                    __builtin_amdgcn_sched_barrier(0); }
            }
        }
        __syncthreads();
    }
#undef SSD_GLOADS
}
__device__ __forceinline__ void gnorm_phase(bf16_t* YS, const float* ng, int gw, int NGW, int lane) {
    for (int row = gw; row < T; row += NGW) {
        bf16_t* p = YS + (size_t)row * SSD_INNER + lane * 8; u32x4 v[8]; float sq[8];
#pragma unroll
        for (int g = 0; g < 8; ++g) v[g] = *(const u32x4*)(p + g * 512);
#pragma unroll
        for (int g = 0; g < 8; ++g) { const float f0 = bflo(v[g].x), f1 = bfhi(v[g].x), f2 = bflo(v[g].y), f3 = bfhi(v[g].y), f4 = bflo(v[g].z), f5 = bfhi(v[g].z), f6 = bflo(v[g].w), f7 = bfhi(v[g].w);
            sq[g] = ((f0 * f0 + f1 * f1) + (f2 * f2 + f3 * f3)) + ((f4 * f4 + f5 * f5) + (f6 * f6 + f7 * f7)); }
#pragma unroll
        for (int o = 1; o < 64; o <<= 1)
#pragma unroll
            for (int g = 0; g < 8; ++g) sq[g] += __shfl_xor(sq[g], o);
#pragma unroll
        for (int g = 0; g < 8; ++g) { const float rstd = rsqrtf(sq[g] * (1.f / 512.f) + EPS);
            const f32x4 g0 = *(const f32x4*)(ng + g * 512 + lane * 8), g1 = *(const f32x4*)(ng + g * 512 + lane * 8 + 4);
            u32x4 o; o.x = cvt_pk_bf16(bflo(v[g].x) * rstd * g0[0], bfhi(v[g].x) * rstd * g0[1]); o.y = cvt_pk_bf16(bflo(v[g].y) * rstd * g0[2], bfhi(v[g].y) * rstd * g0[3]);
            o.z = cvt_pk_bf16(bflo(v[g].z) * rstd * g1[0], bfhi(v[g].z) * rstd * g1[1]); o.w = cvt_pk_bf16(bflo(v[g].w) * rstd * g1[2], bfhi(v[g].w) * rstd * g1[3]);
            *(u32x4*)(p + g * 512) = o; }
    }
}

#define XB_TMO      128
#define XB_XCNT(j)  (256  + 64 * (j))
#define XB_XSUB(j)  (1280 + 64 * (j))
#define XB_XGEN(j)  (2304 + 64 * (j))
#define XB_TOP      3328
#define XB_TOPGEN   3392
#define XCD_BAR_WORDS 3456
#define XB_SPIN_CAP (1u << 18)
__device__ __forceinline__ unsigned xb_ld(unsigned* p)              { return __hip_atomic_load(p, __ATOMIC_RELAXED, __HIP_MEMORY_SCOPE_AGENT); }
__device__ __forceinline__ unsigned xb_add(unsigned* p, unsigned v) { return __hip_atomic_fetch_add(p, v, __ATOMIC_RELAXED, __HIP_MEMORY_SCOPE_AGENT); }
__device__ __forceinline__ unsigned xb_xcc_id() { return (unsigned)__builtin_amdgcn_s_getreg((3 << 11) | 20) & 0xFu; }
#define XB_SPIN(cond, bar) do { unsigned _sp = 0; while (cond) { __builtin_amdgcn_s_sleep(1); \
    if ((++_sp & 255u) == 0u) { if (xb_ld(&(bar)[XB_TMO])) break; if (_sp > XB_SPIN_CAP) { atomicAdd(&(bar)[XB_TMO], 1u); break; } } } } while (0)
struct XcdBarrier { unsigned* bar; unsigned x; volatile LAS unsigned* st; };
__device__ __forceinline__ XcdBarrier xcd_barrier_post(unsigned* bar, volatile LAS unsigned* st) {
    XcdBarrier b; b.bar = bar; b.x = xb_xcc_id(); b.st = st;
    if (threadIdx.x == 0) (void)xb_add(&bar[XB_XCNT(b.x)], 1u);
    return b;
}
__device__ __forceinline__ void xcd_barrier_complete(unsigned* bar, unsigned x, unsigned& nloc, unsigned& nx) {
    const unsigned G = gridDim.x * gridDim.y * gridDim.z;
    unsigned sum, cnt, mine, sp = 0u;
    for (;;) {
        sum = 0u; cnt = 0u; mine = 0u;
#pragma unroll
        for (unsigned j = 0; j < 16; ++j) { const unsigned c = xb_ld(&bar[XB_XCNT(j)]); sum += c; cnt += (c > 0u) ? 1u : 0u; mine = (j == x) ? c : mine; }
        if (sum == G) break;
        __builtin_amdgcn_s_sleep(1);
        if ((++sp & 255u) == 0u) { if (xb_ld(&bar[XB_TMO])) break; if (sp > XB_SPIN_CAP) { atomicAdd(&bar[XB_TMO], 1u); break; } }
    }
    nloc = mine > 0u ? mine : 1u; nx = cnt > 0u ? cnt : 1u;
}
__device__ __forceinline__ void xcd_barrier(const XcdBarrier& b) {
    asm volatile("s_waitcnt vmcnt(0)" ::: "memory");
    __syncthreads();
    if (threadIdx.x == 0) {
        unsigned* bar = b.bar;
        __builtin_amdgcn_s_waitcnt(0);
        unsigned nloc = b.st[0], nx = b.st[1];
        if (nloc == 0u) { xcd_barrier_complete(bar, b.x, nloc, nx); b.st[0] = nloc; b.st[1] = nx; }
        const unsigned old = xb_add(&bar[XB_XSUB(b.x)], 1u);
        const unsigned gen = old / nloc;
        if (old + 1u == (gen + 1u) * nloc) {
            __builtin_amdgcn_fence(__ATOMIC_RELEASE, "agent");
            asm volatile("s_waitcnt vmcnt(0)" ::: "memory");
            const unsigned og = xb_add(&bar[XB_TOP], 1u);
            const unsigned tg = og / nx;
            if (og + 1u == (tg + 1u) * nx) xb_add(&bar[XB_TOPGEN], 1u);
            else XB_SPIN(xb_ld(&bar[XB_TOPGEN]) == tg, bar);
            __builtin_amdgcn_fence(__ATOMIC_ACQUIRE, "agent");
            xb_add(&bar[XB_XGEN(b.x)], 1u);
            asm volatile("s_waitcnt vmcnt(0)" ::: "memory");
        } else {
            XB_SPIN(xb_ld(&bar[XB_XGEN(b.x)]) == gen, bar);
            __builtin_amdgcn_fence(__ATOMIC_ACQUIRE, "agent");
            asm volatile("s_waitcnt vmcnt(0)" ::: "memory");
        }
    }
    __syncthreads();
}

constexpr int NPH = 25;
#ifndef PHMASK
#define PHMASK 0x1ffffff
#endif
#define PH_ON(k) (((PHMASK) >> (k)) & 1)
#ifndef DUPMASK
#define DUPMASK 0
#endif
#ifndef DUPN
#define DUPN 1
#endif
struct Args { const float* in[28]; float* out; unsigned char* ws; int ph_lo, ph_hi; };

__global__ void __launch_bounds__(512) mega(Args a_byval) {
    extern __shared__ __attribute__((aligned(16))) unsigned char lds_raw[];
    cg::grid_group grid = cg::this_grid();
    const int ph_lo = a_byval.ph_lo, ph_hi = a_byval.ph_hi;
    volatile LAS unsigned* misc = (volatile LAS unsigned*)((LAS unsigned char*)lds_raw + 135168);
    if (threadIdx.x < 2) misc[threadIdx.x] = 0u;
    __syncthreads();
    (void)xcd_barrier_post((unsigned*)(a_byval.ws + WS_BAR), misc);
    for (int ph = ph_lo; ph < ph_hi; ++ph) {
        if ((0x641640u >> ph) & 1u) continue;
        const int reps = (ph == 0) ? 2 : (((DUPMASK >> ph) & 1) ? 1 + DUPN : 1);
        for (int rep = 0; rep < reps; ++rep) {
        const __attribute__((address_space(4))) Args* ap = (const __attribute__((address_space(4))) Args*)__builtin_amdgcn_kernarg_segment_ptr();
        asm volatile("" : "+s"(ap));
        int tid = threadIdx.x; asm volatile("" : "+v"(tid));
#define a (*ap)
        LAS unsigned char* lds = (LAS unsigned char*)lds_raw;
        const int lane = tid & 63, wid = __builtin_amdgcn_readfirstlane(tid >> 6);
        int bid_ = blockIdx.x, G_ = gridDim.x; asm volatile("" : "+s"(bid_), "+s"(G_));
        const int bid = bid_, G = G_, gw = bid * 8 + wid, NGW = G * 8, gt = bid * 512 + tid, NGT = G * 512;
        unsigned char* ws = a.ws;
        const float *x = a.in[0], *p = a.in[1], *norm_mix_g = a.in[2], *norm_ffn_g = a.in[3], *norm_ple_g = a.in[4], *final_g = a.in[5];
        bf16_t* U = (bf16_t*)(ws + WS_U); bf16_t* PB = (bf16_t*)(ws + WS_PB); bf16_t* PP = (bf16_t*)(ws + WS_PP);
        const int layer = (ph >= 12 && ph < 24) ? 1 : 0;

        LAS float* scr = (LAS float*)(lds + wid * 8448);
        const int phx = (ph == 0 && rep == 1) ? 12 : ph;
        switch (phx) {
        case 0: case 12: if (!PH_ON(0)) break; {
            const int lyr = (phx == 12) ? 1 : 0;
            int it = gw;
            if (lyr == 0) {
                it = xpose_all(a.in[6], nullptr, 4096, 2048, 4096, 4096, 3, (bf16_t*)(ws + WS_W_IN), it, NGW, scr, lane);
                it = xpose_all(a.in[9], a.in[11], 256, 256, 4096, 4096, 2, (bf16_t*)(ws + WS_W_GATE), it, NGW, scr, lane);
                it = xpose_all(a.in[14], nullptr, 2048, 2048, 2048, 2048, 0, (bf16_t*)(ws + WS_W_AOUT), it, NGW, scr, lane);
                for (int i = gt; i < 2 * T * PLE / 8; i += NGT) { const f32x4 v0 = ((const f32x4*)p)[2 * i], v1 = ((const f32x4*)p)[2 * i + 1];
                    u32x4 o; o.x = cvt_pk_bf16(v0[0], v0[1]); o.y = cvt_pk_bf16(v0[2], v0[3]); o.z = cvt_pk_bf16(v1[0], v1[1]); o.w = cvt_pk_bf16(v1[2], v1[3]); ((u32x4*)PB)[i] = o; }
            } else {
                it = xpose_all(a.in[15], nullptr, SSD_IN, 2048, SSD_IN, SSD_IN, 0, (bf16_t*)(ws + WS_WB_IN), it, NGW, scr, lane, norm_mix_g + D, true);
                it = xpose_all(a.in[22], nullptr, 2048, 4096, 2048, 2048, 0, (bf16_t*)(ws + WS_WB_OUT), it, NGW, scr, lane, nullptr, true);
            }
            it = xpose_all(a.in[23] + (size_t)lyr * D * DFF, a.in[24] + (size_t)lyr * D * DFF, DFF, 2048, 2 * DFF, 2 * DFF, 1, (bf16_t*)(ws + (lyr ? WS_W_GU : WS_W_GU0)), it, NGW, scr, lane, norm_ffn_g + lyr * D, lyr != 0);
            it = xpose_all(a.in[25] + (size_t)lyr * D * DFF, nullptr, 2048, DFF, 2048, 2048, 0, (bf16_t*)(ws + (lyr ? WS_W_D : WS_W_D0)), it, NGW, scr, lane, nullptr, lyr != 0);
            it = xpose_all(a.in[27] + (size_t)lyr * D * D, nullptr, 2048, 2048, 2048, 2048, 0, (bf16_t*)(ws + (lyr ? WS_W_PG1 : WS_W_PG)), it, NGW, scr, lane, norm_ple_g + lyr * D, lyr != 0);
            it = xpose_all(a.in[26] + (size_t)lyr * PLE * D, nullptr, 2048, 256, 2048, 2048, 0, (bf16_t*)(ws + (lyr ? WS_W_PP1 : WS_W_PP)), it, NGW, scr, lane, nullptr, lyr != 0);
            if (lyr == 0) { rms_phase(x, norm_mix_g, U, gw, NGW, lane);
                for (int i = gt; i < 6 * T + 1024; i += NGT) ((ss_t*)(ws + WS_SS))[i] = 0ull;   }
        } break;
        case 1: if (!PH_ON(1)) break; {
            pg8::Gemm g{U, (const bf16_t*)(ws + WS_W_IN), T, 4096, 2048, 2048, 2048, 0}; pg8::StaticOrder S; S.init(T, 4096, G, bid);
            EpiXY E{(bf16_t*)(ws + WS_XRPRE), (bf16_t*)(ws + WS_YG)}; pg8::gemm_phase(lds, g, S, E, tid);
        } break;
        case 2: if (!PH_ON(2)) break; if (gt < D) ((float*)(ws + WS_SPT))[gt] = -8.0f * log1pf(expf(-a.in[13][gt]));
            conv_phase<false>((const bf16_t*)(ws + WS_XRPRE), a.in[7], a.in[8], (bf16_t*)(ws + WS_XRC), D, gt, NGT); break;
        case 3: if (!PH_ON(3)) break; {
            pg8::Gemm g{(const bf16_t*)(ws + WS_XRC), (const bf16_t*)(ws + WS_W_GATE), T, 4096, 256, 2048, 256, 2}; pg8::StaticOrder S; S.init(T, 4096, G, bid);
            EpiGates E{(const bf16_t*)(ws + WS_XRC), a.in[10], a.in[12], (const float*)(ws + WS_SPT), (bf16_t*)(ws + WS_AA), (bf16_t*)(ws + WS_BB)}; pg8::gemm_phase(lds, g, S, E, tid);
        } break;
        case 4: if (!PH_ON(4)) break; lru_scan_phase((const bf16_t*)(ws + WS_AA), (const bf16_t*)(ws + WS_BB), (const bf16_t*)(ws + WS_YG), (bf16_t*)(ws + WS_Y), (LAS float*)lds, tid, bid, G); break;
        case 5: if (!PH_ON(5)) break; {
            pg8::Gemm g{(const bf16_t*)(ws + WS_Y), (const bf16_t*)(ws + WS_W_AOUT), T, 2048, 2048, 2048, 2048, 0}; pg8::StaticOrder S; S.init(T, 2048, G, bid);
            EpiResid<true> E{x, U, (ss_t*)(ws + WS_SS)}; pg8::gemm_phase(lds, g, S, E, tid);
        } break;
        case 7: case 19: if (!PH_ON(7)) break; {
            pg8::Gemm g{U, (const bf16_t*)(ws + (layer ? WS_W_GU : WS_W_GU0)), T, 2 * DFF, 2048, 2048, 2048, 0}; pg8::StaticOrder S; S.init(T, 2 * DFF, G, bid);
            EpiSwiGLU E{(bf16_t*)(ws + WS_ACT), (const ss_t*)(ws + WS_SS) + (layer ? 3 : 0) * T}; pg8::gemm_phase(lds, g, S, E, tid);
        } break;
        case 8: case 20: if (!PH_ON(8)) break; {
            pg8::Gemm g{(const bf16_t*)(ws + WS_ACT), (const bf16_t*)(ws + (layer ? WS_W_D : WS_W_D0)), T, 2048, DFF, DFF, DFF, 0}; pg8::StaticOrder S; S.init(T, 2048, G, bid);
            EpiResid<false> E{U, U, (ss_t*)(ws + WS_SS) + (layer ? 4 : 1) * T}; pg8::gemm_phase(lds, g, S, E, tid);
        } break;
        case 11: case 23: if (!PH_ON(11)) break; {
            pg8::StaticOrder S; S.init(T, 2048, G, bid);
            { pg8::Gemm g{PB + (size_t)layer * T * PLE, (const bf16_t*)(ws + (layer ? WS_W_PP1 : WS_W_PP)), T, 2048, 256, 256, 256, 0}; EpiPP4 E{PP}; pg8::gemm_phase(lds, g, S, E, tid); }
            pg8::Gemm g{U, (const bf16_t*)(ws + (layer ? WS_W_PG1 : WS_W_PG)), T, 2048, 2048, 2048, 2048, 0};
            if (layer == 0) { EpiPle<true> E{U, PP, (const ss_t*)(ws + WS_SS) + 1 * T, (bf16_t*)(ws + WS_U2), (ss_t*)(ws + WS_SS) + 2 * T}; pg8::gemm_phase(lds, g, S, E, tid); }
            else if (G == 256) { EpiPleFinal E{U, PP, (const ss_t*)(ws + WS_SS) + 4 * T, (ss_t*)(ws + WS_SS) + 5 * T, (unsigned*)(ws + WS_CNT), final_g, a.out}; pg8::gemm_phase(lds, g, S, E, tid); }
            else { EpiPle<false> E{U, PP, (const ss_t*)(ws + WS_SS) + 4 * T, (bf16_t*)(ws + WS_U2), nullptr}; pg8::gemm_phase(lds, g, S, E, tid); }
        } break;
        case 13: if (!PH_ON(13)) break; {
            pg8::Gemm g{(const bf16_t*)(ws + WS_U2), (const bf16_t*)(ws + WS_WB_IN), T, 10240, 2048, 2048, 2048, 0}; pg8::StaticOrder S; S.init(T, 10240, G, bid);
            EpiSsdIn E{(bf16_t*)(ws + WS_Z), (bf16_t*)(ws + WS_XBCPRE), (const ss_t*)(ws + WS_SS) + 2 * T}; pg8::gemm_phase(lds, g, S, E, tid);
            if (bid < 256) {
                const int ks = bid >> 5;
                pg8::Gemm g2{(const bf16_t*)(ws + WS_U2) + ks * 256, (const bf16_t*)(ws + WS_WB_IN) + (size_t)10240 * 2048 + ks * 256, T, 256, 256, 2048, 2048, 0}; pg8::StaticOrder S2; S2.init(T, 256, 32, bid & 31);
                EpiDtPart E2{(float*)(ws + WS_DTP) + (size_t)ks * T * SSD_H}; pg8::gemm_phase(lds, g2, S2, E2, tid); }
        } break;
        case 14: if (!PH_ON(14)) break; conv_phase<true>((const bf16_t*)(ws + WS_XBCPRE), a.in[16], a.in[17], (bf16_t*)(ws + WS_XBC), SSD_CONV, gt, NGT); break;
        case 15: if (!PH_ON(15)) break; ssd_phase((const bf16_t*)(ws + WS_XBC), (const float*)(ws + WS_DTP), (const ss_t*)(ws + WS_SS) + 2 * T, a.in[18], (const bf16_t*)(ws + WS_Z), a.in[19], a.in[20], (bf16_t*)(ws + WS_YS), lds, tid, wid, lane, bid, G); break;
        case 16: if (!PH_ON(16)) break; gnorm_phase((bf16_t*)(ws + WS_YS), a.in[21], gw, NGW, lane); break;
        case 17: if (!PH_ON(17)) break; {
            pg8::Gemm g{(const bf16_t*)(ws + WS_YS), (const bf16_t*)(ws + WS_WB_OUT), T, 2048, 4096, 4096, 4096, 0}; pg8::StaticOrder S; S.init(T, 2048, G, bid);
            EpiResid<false> E{(const bf16_t*)(ws + WS_U2), U, (ss_t*)(ws + WS_SS) + 3 * T}; pg8::gemm_phase(lds, g, S, E, tid);
        } break;
        case 24: if (!PH_ON(24)) break; if (G != 256) final_norm_phase((const bf16_t*)(ws + WS_U2), final_g, a.out, gw, NGW, lane); break;
        default: break;
        }
        if (rep + 1 < reps) continue;
        if (ph + 1 < ph_hi) { if (ph_hi > 64) grid.sync();   else { XcdBarrier xbar; xbar.bar = (unsigned*)(ws + WS_BAR); xbar.x = xb_xcc_id(); xbar.st = (volatile LAS unsigned*)((LAS unsigned char*)lds_raw + 135168); xcd_barrier(xbar); } }
#undef a
        }
    }
}

extern "C" void kernel_launch(void* const* d_in, const int* in_sizes, int n_in, void* d_out, int out_size, void* d_ws, size_t ws_size, hipStream_t stream) {
    static int grid = 0;
    if (grid == 0) {
        if (n_in != 28 || out_size != T * D || ws_size < WS_END) { fprintf(stderr, "kernel_launch: unexpected shapes (n_in %d out %d ws %zu need %zu)\n", n_in, out_size, ws_size, (size_t)WS_END); grid = -1; return; }
        int dev = 0, cus = 0, per_cu = 0;
        hipGetDevice(&dev); hipDeviceGetAttribute(&cus, hipDeviceAttributeMultiprocessorCount, dev);
        if (hipFuncSetAttribute((const void*)mega, hipFuncAttributeMaxDynamicSharedMemorySize, LDS_BYTES) != hipSuccess) { fprintf(stderr, "kernel_launch: hipFuncSetAttribute failed\n"); grid = -1; return; }
        if (hipOccupancyMaxActiveBlocksPerMultiprocessor(&per_cu, (const void*)mega, 512, LDS_BYTES) != hipSuccess || per_cu < 1) { fprintf(stderr, "kernel_launch: occupancy query failed (%d)\n", per_cu); (void)hipGetLastError(); per_cu = 1; }
        grid = cus * per_cu;
        fprintf(stderr, "kernel_launch: grid %d (cus %d x %d), ws %zu\n", grid, cus, per_cu, ws_size);
    }
    if (grid < 0) return;
    Args a{};
    for (int i = 0; i < 28; ++i) a.in[i] = (const float*)d_in[i];
    a.out = (float*)d_out; a.ws = (unsigned char*)d_ws;
#if ONE_LAUNCH
    if (hipMemsetAsync((unsigned char*)d_ws + WS_BAR, 0, XCD_BAR_WORDS * 4, stream) != hipSuccess) { fprintf(stderr, "kernel_launch: memset of barrier words failed\n"); return; }
    a.ph_lo = 0; a.ph_hi = (grid == 256) ? NPH - 1 : NPH;
    void* kargs[] = {&a};
    hipError_t e = hipLaunchCooperativeKernel((const void*)mega, dim3(grid), dim3(512), kargs, LDS_BYTES, stream);
    if (e != hipSuccess) fprintf(stderr, "cooperative launch failed: %s (grid %d)\n", hipGetErrorString(e), grid);
    return;
#endif
    unsigned char* ws = (unsigned char*)d_ws;
    for (int ph = 0; ph < NPH; ++ph) {
        a.ph_lo = ph; a.ph_hi = ph + 1; hipLaunchKernelGGL(mega, dim3(grid), dim3(512), LDS_BYTES, stream, a); }
}
```

```cpp
#include <hip/hip_runtime.h>
#include <hip/hip_cooperative_groups.h>
#include <cstdio>
#include <cstdint>
namespace cg = cooperative_groups;

#ifndef ONE_LAUNCH
#define ONE_LAUNCH 1
#endif

#define LAS __attribute__((address_space(3)))
typedef unsigned short bf16_t;
typedef short bf16x8 __attribute__((ext_vector_type(8)));
typedef float f32x4 __attribute__((ext_vector_type(4)));
typedef float f32x2 __attribute__((ext_vector_type(2)));
typedef unsigned u32x4 __attribute__((ext_vector_type(4)));
typedef unsigned u32x2 __attribute__((ext_vector_type(2)));
typedef unsigned long long ss_t;
__device__ __forceinline__ void ss_add(ss_t* p, float v) { (void)__hip_atomic_fetch_add(p, (ss_t)(v * 1048576.0f), __ATOMIC_RELAXED, __HIP_MEMORY_SCOPE_AGENT); }
__device__ __forceinline__ float ss_rstd(const ss_t* p) { return rsqrtf((float)(*p) * (1.0f / (1048576.0f * 2048.0f)) + 1e-6f); }

constexpr int T = 8192, D = 2048, SEQ = 2048, DFF = 5632, PLE = 256;
constexpr int SSD_INNER = 4096, SSD_CONV = 6144, SSD_IN = 10304, SSD_IN_PAD = 10496, SSD_H = 64;
constexpr float EPS = 1e-6f;

constexpr size_t MB = 1ull << 20;
constexpr size_t WS_W_IN = 0;
constexpr size_t WS_W_GATE = 16 * MB, WS_W_AOUT = 18 * MB;
constexpr size_t WS_W_BOUT = 41 * MB;
constexpr size_t WS_W_GU = 57 * MB;
constexpr size_t WS_W_D = 101 * MB;
constexpr size_t WS_W_PG = 123 * MB;
constexpr size_t WS_W_PP = 131 * MB;
constexpr size_t WS_W_PG1 = 26 * MB, WS_W_PP1 = 34 * MB;
constexpr size_t WS_WB_IN = 132 * MB;
constexpr size_t WS_WB_OUT = 173 * MB;
constexpr size_t WS_PB = 196 * MB;
constexpr size_t WS_PP = 204 * MB;
constexpr size_t WS_U = 236 * MB;
constexpr size_t WS_AR = 268 * MB;
constexpr size_t WS_XRPRE = WS_AR, WS_YG = WS_AR + 32 * MB, WS_XRC = WS_AR + 64 * MB, WS_AA = WS_AR + 96 * MB, WS_BB = WS_AR + 160 * MB, WS_Y = WS_AR;
constexpr size_t WS_ACT = WS_AR;
constexpr size_t WS_Z = WS_AR, WS_XBCPRE = WS_AR + 64 * MB, WS_XBC = WS_AR + 160 * MB, WS_DT = WS_AR + 256 * MB, WS_YS = WS_AR + 64 * MB;
constexpr size_t WS_W_GU0 = WS_AR + 192 * MB, WS_W_D0 = WS_AR + 236 * MB;
constexpr size_t WS_SPT = WS_AR + 258 * MB + 524288;
constexpr size_t WS_BAR = WS_AR + 258 * MB;
constexpr size_t WS_CNT = WS_BAR + 65536 + 6 * 65536;
constexpr size_t WS_SS = WS_BAR + 65536;
constexpr size_t WS_U2 = WS_PP;
constexpr size_t WS_DTP = WS_U;
constexpr size_t WS_END = WS_AR + 259 * MB;

constexpr int LDS_BYTES = 139264;

__device__ __forceinline__ unsigned cvt_pk_bf16(float lo, float hi) { unsigned r; asm volatile("v_cvt_pk_bf16_f32 %0, %1, %2" : "=v"(r) : "v"(lo), "v"(hi)); return r; }
__device__ __forceinline__ float bf2f(unsigned short v) { return __uint_as_float(((unsigned)v) << 16); }
__device__ __forceinline__ float bflo(unsigned w) { return __uint_as_float(w << 16); }
__device__ __forceinline__ float bfhi(unsigned w) { return __uint_as_float(w & 0xffff0000u); }
__device__ __forceinline__ float fsigmoid(float x) { return __builtin_amdgcn_rcpf(1.0f + __expf(-x)); }
__device__ __forceinline__ float fsilu(float x) { return x * fsigmoid(x); }
__device__ __forceinline__ void sigmoid2(float x0, float x1, float& s0, float& s1) {
    const float d0 = 1.0f + __builtin_amdgcn_exp2f(fminf(x0 * -1.4426950408889634f, 60.f)), d1 = 1.0f + __builtin_amdgcn_exp2f(fminf(x1 * -1.4426950408889634f, 60.f));
    const float rp = __builtin_amdgcn_rcpf(d0 * d1); s0 = rp * d1; s1 = rp * d0; }
__device__ __forceinline__ f32x4 sigmoid4(f32x4 x) { float a, b, c, d; sigmoid2(x[0], x[1], a, b); sigmoid2(x[2], x[3], c, d); return (f32x4){a, b, c, d}; }
__device__ __forceinline__ f32x4 gelu_tanh4(f32x4 v) { const f32x4 z = (v * v * 0.044715f + 1.0f) * v * 1.5957691216057308f; return v * sigmoid4(z); }
__device__ __forceinline__ float fgelu_tanh(float v) { return v * fsigmoid(1.5957691216057308f * (v + 0.044715f * v * v * v)); }
__device__ __forceinline__ float fsoftplus(float x) { return x > 20.f ? x : __logf(1.0f + __expf(x)); }
__device__ __forceinline__ float neg_expm1_small(float x) { return -x * (1.0f + x * (0.5f + x * (0.16666667f + x * (0.041666668f + x * (0.0083333338f + x * 0.0013888889f))))); }
__device__ __forceinline__ float wave_sum(float v) {
#pragma unroll
    for (int o = 1; o < 64; o <<= 1) v += __shfl_xor(v, o);
    return v;
}

namespace pg8 {
constexpr int BM = 256, BK = 64, HALF = 128, HTB = HALF * BK * 2, STAGE_BYTES = 8 * HTB, NXCD = 8, WGM = 8;
__host__ __device__ __forceinline__ int lds_byte(int r, int c) { const int st = (r >> 4) * 2 + (c >> 5), rr = r & 15, cc = c & 31, ob = rr * 64 + cc * 2; return st * 1024 + (ob ^ (((ob >> 9) & 1) << 5)); }
__host__ __device__ __forceinline__ void stage_rc(int b, int& R, int& C) { const int st = b / 1024, sb = b % 1024, swz = sb ^ (((sb >> 9) & 1) << 5); R = (st >> 1) * 16 + swz / 64; C = (st & 1) * 32 + (swz % 64) / 2; }
__host__ __device__ __forceinline__ int perm32(int rho) { const int n = rho >> 4, i = rho & 15; return 8 * (i >> 2) + 4 * n + (i & 3); }

struct Unit { int pm, pn; };
struct Gemm { const bf16_t* A; const bf16_t* Bt; int M, N, K, lda, ldb, adiv; };

struct StaticOrder {
    int nM, nN, nwg, G, c;
    __device__ void init(int M, int N, int G_, int c_) { nM = M / BM; nN = N / BM; nwg = nM * nN; G = G_; c = c_; }
    __device__ bool next(int i, Unit& u) const {
        const long L = (long)i * G + c; if (L >= nwg) return false;
        int wgid = (int)L; { const int q = nwg / NXCD, r = nwg % NXCD, xcd = wgid % NXCD, off = wgid / NXCD; wgid = (xcd < r ? xcd * (q + 1) : r * (q + 1) + (xcd - r) * q) + off; }
        const int nig = WGM * nN, gid = wgid / nig, fm = gid * WGM, gsz = (nM - fm) < WGM ? (nM - fm) : WGM;
        u.pm = __builtin_amdgcn_readfirstlane(fm + ((wgid % nig) % gsz)); u.pn = __builtin_amdgcn_readfirstlane((wgid % nig) / gsz); return true;
    }
};

template <class Epi>
__device__ __forceinline__ void gemm_phase(LAS unsigned char* lds, const Gemm g, const StaticOrder& S, const Epi& E, const int tid) {
    const int wid = __builtin_amdgcn_readfirstlane(tid >> 6), lane = tid & 63, wr = wid >> 2, wc = wid & 3, fr = lane & 15, fq = lane >> 4;
    int K_ = g.K; asm volatile("" : "+s"(K_));
    const int K = K_, nt = K / BK;
    unsigned voffA[2], voffB[2];
#pragma unroll
    for (int i = 0; i < 2; ++i) { int R, C; stage_rc(tid * 16 + i * 8192, R, C); const int Rb = Epi::PERM ? ((R & ~31) + perm32(R & 31)) : R;
        voffA[i] = (unsigned)(R * g.lda + C) * 2u; voffB[i] = (unsigned)(Rb * g.ldb + C) * 2u; }
    const size_t kstep = (size_t)(BK * 2);
    const size_t hstepA = (size_t)HALF * g.lda * 2, hstepB = (size_t)HALF * g.ldb * 2;
    const size_t tstepA = 2 * hstepA, tstepB = 2 * hstepB;
    const unsigned ldsw = (unsigned)wid * 1024u;
    const int aoff = lds_byte(wr * 64 + fr, fq * 8), boff = lds_byte(wc * 32 + fr, fq * 8);
#define PG8_APTR(u) ((const char*)g.A + (size_t)(u).pm * tstepA + (g.adiv ? (size_t)((u).pn >> 1) * (size_t)K * 2 : (size_t)0))
#define PG8_BPTR(u) ((const char*)g.Bt + (size_t)(u).pn * tstepB)
#define PG8_SA(b, h) (((b) * 2 + (h)) * HTB)
#define PG8_SB(b, h) ((4 + (b) * 2 + (h)) * HTB)
#define PG8_STAGE(bufoff, gbase, voff) do { _Pragma("unroll") for (int _i = 0; _i < 2; ++_i) \
        __builtin_amdgcn_global_load_lds((const unsigned*)((const char*)(gbase) + (voff)[_i]), (LAS unsigned*)(lds + (bufoff) + ldsw + _i * 8192), 16, 0, 0); } while (0)
#define PG8_LDA(dst, b, h) do { _Pragma("unroll") for (int m = 0; m < 4; ++m) _Pragma("unroll") for (int k = 0; k < 2; ++k) dst[m][k] = *(const LAS bf16x8*)(lds + PG8_SA(b, h) + aoff + m * 2048 + k * 1024); } while (0)
#define PG8_LDB(dst, b, h) do { _Pragma("unroll") for (int n = 0; n < 2; ++n) _Pragma("unroll") for (int k = 0; k < 2; ++k) dst[n][k] = *(const LAS bf16x8*)(lds + PG8_SB(b, h) + boff + n * 2048 + k * 1024); } while (0)
#define PG8_MMA(ai, bj, At, Bt) do { __builtin_amdgcn_s_setprio(1); _Pragma("unroll") for (int m = 0; m < 4; ++m) _Pragma("unroll") for (int n = 0; n < 2; ++n) _Pragma("unroll") for (int k = 0; k < 2; ++k) \
        acc[ai][bj][m][n] = __builtin_amdgcn_mfma_f32_16x16x32_bf16(Bt[n][k], At[m][k], acc[ai][bj][m][n], 0, 0, 0); __builtin_amdgcn_s_setprio(0); } while (0)
#define PG8_WAIT_V(n) asm volatile("s_waitcnt vmcnt(" #n ")" ::: "memory")
#define PG8_WAIT_L(n) asm volatile("s_waitcnt lgkmcnt(" #n ")" ::: "memory")
#define PG8_BAR __builtin_amdgcn_s_barrier()
#define PG8_SCHED __builtin_amdgcn_sched_barrier(0)
    Unit cur, nxt; int ui = 0;
    if (!S.next(0, cur)) return;
    f32x4 acc[2][2][4][2];
#pragma unroll
    for (int a = 0; a < 2; ++a)
#pragma unroll
        for (int b = 0; b < 2; ++b)
#pragma unroll
            for (int m = 0; m < 4; ++m)
#pragma unroll
                for (int n = 0; n < 2; ++n) acc[a][b][m][n] = (f32x4){0.f, 0.f, 0.f, 0.f};
    bf16x8 At[4][2], B0[2][2], B1[2][2];
    const char* cA = PG8_APTR(cur); const char* cB = PG8_BPTR(cur);
    PG8_STAGE(PG8_SB(0, 0), cB, voffB); PG8_STAGE(PG8_SB(0, 1), cB + hstepB, voffB); PG8_STAGE(PG8_SA(0, 0), cA, voffA); PG8_STAGE(PG8_SA(0, 1), cA + hstepA, voffA);
    if (wr == 1) PG8_BAR;
    PG8_WAIT_V(2); PG8_BAR;
    PG8_STAGE(PG8_SB(1, 0), cB + kstep, voffB); PG8_STAGE(PG8_SA(1, 0), cA + kstep, voffA); PG8_STAGE(PG8_SB(1, 1), cB + hstepB + kstep, voffB);
    PG8_WAIT_V(6); PG8_BAR;
    for (;;) {
        const bool has_next = S.next(ui + 1, nxt);
        const char* nA = has_next ? PG8_APTR(nxt) : cA; const char* nB = has_next ? PG8_BPTR(nxt) : cB;
        for (int t = 0; t < nt; t += 2) {
            const bool last = (t == nt - 2);
            const char* a1 = cA + (size_t)(t + 1) * kstep;
            const char* a2 = last ? nA : cA + (size_t)(t + 2) * kstep; const char* b2 = last ? nB : cB + (size_t)(t + 2) * kstep;
            const char* a3 = a2 + kstep; const char* b3 = b2 + kstep;
            PG8_LDB(B0, 0, 0); PG8_LDB(B1, 0, 1); PG8_SCHED; PG8_LDA(At, 0, 0); PG8_STAGE(PG8_SA(1, 1), a1 + hstepA, voffA);
            PG8_WAIT_V(8); PG8_WAIT_L(0); PG8_BAR; PG8_MMA(0, 0, At, B0); PG8_MMA(0, 1, At, B1); PG8_BAR; PG8_SCHED;
            PG8_LDA(At, 0, 1); PG8_STAGE(PG8_SB(0, 0), b2, voffB); PG8_STAGE(PG8_SB(0, 1), b2 + hstepB, voffB); PG8_STAGE(PG8_SA(0, 0), a2, voffA);
            PG8_WAIT_V(8); PG8_WAIT_L(0); PG8_BAR; PG8_MMA(1, 0, At, B0); PG8_MMA(1, 1, At, B1); PG8_BAR; PG8_SCHED;
            PG8_LDB(B0, 1, 0); PG8_LDB(B1, 1, 1); PG8_SCHED; PG8_LDA(At, 1, 0); PG8_STAGE(PG8_SA(0, 1), a2 + hstepA, voffA);
            PG8_WAIT_V(8); PG8_WAIT_L(0); PG8_BAR; PG8_MMA(0, 0, At, B0); PG8_MMA(0, 1, At, B1); PG8_BAR; PG8_SCHED;
            PG8_LDA(At, 1, 1); PG8_STAGE(PG8_SB(1, 0), b3, voffB); PG8_STAGE(PG8_SB(1, 1), b3 + hstepB, voffB); PG8_STAGE(PG8_SA(1, 0), a3, voffA);
            PG8_WAIT_V(8); PG8_WAIT_L(0); PG8_BAR; PG8_MMA(1, 0, At, B0); PG8_MMA(1, 1, At, B1); PG8_BAR; PG8_SCHED;
        }
        if (wr == 0) PG8_BAR;
        E(acc, cur, wr, wc, fr, fq);
        if (!has_next) break;
#pragma unroll
        for (int a = 0; a < 2; ++a)
#pragma unroll
            for (int b = 0; b < 2; ++b)
#pragma unroll
                for (int m = 0; m < 4; ++m)
#pragma unroll
                    for (int n = 0; n < 2; ++n) acc[a][b][m][n] = (f32x4){0.f, 0.f, 0.f, 0.f};
        cur = nxt; cA = nA; cB = nB; ++ui;
        if (wr == 1) PG8_BAR;
    }
    PG8_WAIT_V(0);
    PG8_BAR;
#undef PG8_APTR
#undef PG8_BPTR
#undef PG8_SA
#undef PG8_SB
#undef PG8_STAGE
#undef PG8_LDA
#undef PG8_LDB
#undef PG8_MMA
#undef PG8_WAIT_V
#undef PG8_WAIT_L
#undef PG8_BAR
#undef PG8_SCHED
}
}
using pg8::Unit;

struct EpiXY {
    static constexpr bool PERM = true;
    bf16_t* XR; bf16_t* YG;
    __device__ __forceinline__ void operator()(const f32x4 (&acc)[2][2][4][2], const Unit& u, int wr, int wc, int fr, int fq) const {
        const int row0 = u.pm * 256 + wr * 64 + fr; const bool isg = (u.pn >> 2) & 1;
        bf16_t* base = isg ? YG : XR; const int col0 = ((u.pn & 3) + 4 * (u.pn >> 3)) * 256 + wc * 32 + 8 * fq;
#pragma unroll
        for (int ai = 0; ai < 2; ++ai)
#pragma unroll
            for (int m = 0; m < 4; ++m) { bf16_t* rowp = base + (size_t)(row0 + ai * 128 + m * 16) * D + col0;
#pragma unroll
                for (int bj = 0; bj < 2; ++bj) { f32x4 v0 = acc[ai][bj][m][0], v1 = acc[ai][bj][m][1];
                    if (isg) { v0 = gelu_tanh4(v0); v1 = gelu_tanh4(v1); }
                    u32x4 w; w.x = cvt_pk_bf16(v0[0], v0[1]); w.y = cvt_pk_bf16(v0[2], v0[3]); w.z = cvt_pk_bf16(v1[0], v1[1]); w.w = cvt_pk_bf16(v1[2], v1[3]);
                    *(u32x4*)(rowp + bj * 128) = w; } }
    }
};
struct EpiBf16 {
    static constexpr bool PERM = true;
    bf16_t* O; int ldc;
    __device__ __forceinline__ void operator()(const f32x4 (&acc)[2][2][4][2], const Unit& u, int wr, int wc, int fr, int fq) const {
        const int row0 = u.pm * 256 + wr * 64 + fr; const int col0 = u.pn * 256 + wc * 32 + 8 * fq;
#pragma unroll
        for (int ai = 0; ai < 2; ++ai)
#pragma unroll
            for (int m = 0; m < 4; ++m) { bf16_t* rowp = O + (size_t)(row0 + ai * 128 + m * 16) * ldc + col0;
#pragma unroll
                for (int bj = 0; bj < 2; ++bj) { const f32x4 v0 = acc[ai][bj][m][0], v1 = acc[ai][bj][m][1];
                    u32x4 w; w.x = cvt_pk_bf16(v0[0], v0[1]); w.y = cvt_pk_bf16(v0[2], v0[3]); w.z = cvt_pk_bf16(v1[0], v1[1]); w.w = cvt_pk_bf16(v1[2], v1[3]);
                    *(u32x4*)(rowp + bj * 128) = w; } }
    }
};
struct EpiGates {
    static constexpr bool PERM = false;
    const bf16_t* XRC; const float* br; const float* bi; const float* spt; bf16_t* DD; bf16_t* BB;
    __device__ __forceinline__ void operator()(const f32x4 (&acc)[2][2][4][2], const Unit& u, int wr, int wc, int fr, int fq) const {
        const int row0 = u.pm * 256 + wr * 64 + fr; const int chb = (u.pn >> 1) * 256 + (u.pn & 1) * 128 + wc * 32 + 4 * fq;
#pragma unroll
        for (int n = 0; n < 2; ++n) { const int ch = chb + 16 * n;
            const f32x4 br4 = *(const f32x4*)(br + ch), bi4 = *(const f32x4*)(bi + ch), sp4 = *(const f32x4*)(spt + ch);
            const bool slow = __ballot(fminf(fminf(sp4[0], sp4[1]), fminf(sp4[2], sp4[3])) <= -0.25f) != 0ull;
#pragma unroll
            for (int ai = 0; ai < 2; ++ai)
#pragma unroll
                for (int m = 0; m < 4; ++m) { const size_t off = (size_t)(row0 + ai * 128 + m * 16) * D + ch;
                    const u32x2 xw = *(const u32x2*)(XRC + off);
                    const float xr[4] = {bflo(xw.x), bfhi(xw.x), bflo(xw.y), bfhi(xw.y)};
                    f32x4 dv, bv;
#pragma unroll
                    for (int j = 0; j < 4; ++j) { float r, ig; sigmoid2(acc[ai][0][m][n][j] + br4[j], acc[ai][1][m][n][j] + bi4[j], r, ig);
                        const float la = r * sp4[j]; float dd = neg_expm1_small(la); if (slow) dd = la > -0.25f ? dd : 1.0f - __expf(la);
                        dv[j] = dd; bv[j] = __builtin_sqrtf(dd * (2.0f - dd)) * ig * xr[j]; }
                    u32x2 dw, bw; dw.x = cvt_pk_bf16(dv[0], dv[1]); dw.y = cvt_pk_bf16(dv[2], dv[3]); bw.x = cvt_pk_bf16(bv[0], bv[1]); bw.y = cvt_pk_bf16(bv[2], bv[3]);
                    *(u32x2*)(DD + off) = dw; *(u32x2*)(BB + off) = bw; asm volatile("" ::: "memory"); } }
    }
};
__device__ __forceinline__ void load_rstd(const ss_t* SS, int row0, float (&rs)[2][4]) {
#pragma unroll
    for (int ai = 0; ai < 2; ++ai)
#pragma unroll
        for (int m = 0; m < 4; ++m) rs[ai][m] = ss_rstd(SS + row0 + ai * 128 + m * 16);
}
template <bool XF32>
struct EpiResid {
    static constexpr bool PERM = true;
    const void* base; bf16_t* HB; ss_t* SS;
    __device__ __forceinline__ void operator()(const f32x4 (&acc)[2][2][4][2], const Unit& u, int wr, int wc, int fr, int fq) const {
        const int row0 = u.pm * 256 + wr * 64 + fr, col0 = u.pn * 256 + wc * 32 + 8 * fq;
#pragma unroll
        for (int ai = 0; ai < 2; ++ai)
#pragma unroll
            for (int m = 0; m < 4; ++m) { const int row = row0 + ai * 128 + m * 16; const size_t off = (size_t)row * D + col0; float sq = 0.f;
#pragma unroll
                for (int bj = 0; bj < 2; ++bj) { const size_t o = off + bj * 128; f32x4 b0, b1;
                    if (XF32) { b0 = *(const f32x4*)((const float*)base + o); b1 = *(const f32x4*)((const float*)base + o + 4); }
                    else { const u32x4 hw = *(const u32x4*)((const bf16_t*)base + o); b0 = (f32x4){bflo(hw.x), bfhi(hw.x), bflo(hw.y), bfhi(hw.y)}; b1 = (f32x4){bflo(hw.z), bfhi(hw.z), bflo(hw.w), bfhi(hw.w)}; }
                    const f32x4 r0 = b0 + acc[ai][bj][m][0], r1 = b1 + acc[ai][bj][m][1];
                    u32x4 hb; hb.x = cvt_pk_bf16(r0[0], r0[1]); hb.y = cvt_pk_bf16(r0[2], r0[3]); hb.z = cvt_pk_bf16(r1[0], r1[1]); hb.w = cvt_pk_bf16(r1[2], r1[3]); *(u32x4*)(HB + o) = hb;
                    sq += ((r0[0] * r0[0] + r0[1] * r0[1]) + (r0[2] * r0[2] + r0[3] * r0[3])) + ((r1[0] * r1[0] + r1[1] * r1[1]) + (r1[2] * r1[2] + r1[3] * r1[3])); }
                sq += __shfl_xor(sq, 16); sq += __shfl_xor(sq, 32);
                if (fq == 0) ss_add(SS + row, sq);
                if (m & 1) asm volatile("" ::: "memory"); }
    }
};
struct EpiSwiGLU {
    static constexpr bool PERM = true;
    bf16_t* ACT; const ss_t* SS;
    __device__ __forceinline__ void operator()(const f32x4 (&acc)[2][2][4][2], const Unit& u, int wr, int wc, int fr, int fq) const {
        const int row0 = u.pm * 256 + wr * 64 + fr, col0 = u.pn * 128 + wc * 32 + 8 * fq;
        float rs[2][4]; load_rstd(SS, row0, rs);
#pragma unroll
        for (int ai = 0; ai < 2; ++ai)
#pragma unroll
            for (int m = 0; m < 4; ++m) { const float r = rs[ai][m];
                const f32x4 g0 = acc[ai][0][m][0] * r, g1 = acc[ai][0][m][1] * r, u0 = acc[ai][1][m][0] * r, u1 = acc[ai][1][m][1] * r;
                const f32x4 v0 = g0 * sigmoid4(g0) * u0, v1 = g1 * sigmoid4(g1) * u1;
                u32x4 w; w.x = cvt_pk_bf16(v0[0], v0[1]); w.y = cvt_pk_bf16(v0[2], v0[3]); w.z = cvt_pk_bf16(v1[0], v1[1]); w.w = cvt_pk_bf16(v1[2], v1[3]);
                *(u32x4*)(ACT + (size_t)(row0 + ai * 128 + m * 16) * DFF + col0) = w; }
    }
};
struct EpiPP4 {
    static constexpr bool PERM = false;
    bf16_t* PP;
    __device__ __forceinline__ void operator()(const f32x4 (&acc)[2][2][4][2], const Unit& u, int wr, int wc, int fr, int fq) const {
        const int row0 = u.pm * 256 + wr * 64 + fr, col0 = u.pn * 256 + wc * 32 + 4 * fq;
#pragma unroll
        for (int ai = 0; ai < 2; ++ai)
#pragma unroll
            for (int m = 0; m < 4; ++m) { const size_t off = (size_t)(row0 + ai * 128 + m * 16) * D + col0;
#pragma unroll
                for (int bj = 0; bj < 2; ++bj)
#pragma unroll
                    for (int n = 0; n < 2; ++n) { const f32x4 v = acc[ai][bj][m][n]; u32x2 w; w.x = cvt_pk_bf16(v[0], v[1]); w.y = cvt_pk_bf16(v[2], v[3]); *(u32x2*)(PP + off + bj * 128 + n * 16) = w; } }
    }
};
template <bool EMIT>
struct EpiPle {
    static constexpr bool PERM = false;
    const bf16_t* HBi; const bf16_t* PP; const ss_t* SSi; bf16_t* HBo; ss_t* SSo;
    __device__ __forceinline__ void operator()(const f32x4 (&acc)[2][2][4][2], const Unit& u, int wr, int wc, int fr, int fq) const {
        const int row0 = u.pm * 256 + wr * 64 + fr, col0 = u.pn * 256 + wc * 32 + 4 * fq;
#pragma unroll
        for (int ai = 0; ai < 2; ++ai)
#pragma unroll
            for (int m = 0; m < 4; ++m) { const int row = row0 + ai * 128 + m * 16; const size_t off = (size_t)row * D + col0; const float rr = ss_rstd(SSi + row); float sq = 0.f;
#pragma unroll
                for (int bj = 0; bj < 2; ++bj)
#pragma unroll
                    for (int n = 0; n < 2; ++n) { const size_t o = off + bj * 128 + n * 16; const u32x2 hw = *(const u32x2*)(HBi + o); const u32x2 pw = *(const u32x2*)(PP + o);
                        const f32x4 a = acc[ai][bj][m][n]; f32x4 r;
                        r[0] = bflo(hw.x) + fsigmoid(rr * a[0]) * bflo(pw.x); r[1] = bfhi(hw.x) + fsigmoid(rr * a[1]) * bfhi(pw.x); r[2] = bflo(hw.y) + fsigmoid(rr * a[2]) * bflo(pw.y); r[3] = bfhi(hw.y) + fsigmoid(rr * a[3]) * bfhi(pw.y);
                        u32x2 hb; hb.x = cvt_pk_bf16(r[0], r[1]); hb.y = cvt_pk_bf16(r[2], r[3]); *(u32x2*)(HBo + o) = hb;
                        if (EMIT) sq += (r[0] * r[0] + r[1] * r[1]) + (r[2] * r[2] + r[3] * r[3]); }
                if (EMIT) { sq += __shfl_xor(sq, 16); sq += __shfl_xor(sq, 32); if (fq == 0) ss_add(SSo + row, sq); }
                asm volatile("" ::: "memory"); }
    }
};
struct EpiPleFinal {
    static constexpr bool PERM = false;
    const bf16_t* HBi; const bf16_t* PP; const ss_t* SSi; ss_t* SSo; unsigned* cnt; const float* gfin; float* out;
    __device__ __forceinline__ void operator()(const f32x4 (&acc_)[2][2][4][2], const Unit& u, int wr, int wc, int fr, int fq) const {
        f32x4 (&acc)[2][2][4][2] = const_cast<f32x4 (&)[2][2][4][2]>(acc_);
        const int row0 = u.pm * 256 + wr * 64 + fr, col0 = u.pn * 256 + wc * 32 + 4 * fq;
#pragma unroll
        for (int ai = 0; ai < 2; ++ai)
#pragma unroll
            for (int m = 0; m < 4; ++m) { const int row = row0 + ai * 128 + m * 16; const size_t off = (size_t)row * D + col0; const float rr = ss_rstd(SSi + row); float sq = 0.f;
#pragma unroll
                for (int bj = 0; bj < 2; ++bj)
#pragma unroll
                    for (int n = 0; n < 2; ++n) { const size_t o = off + bj * 128 + n * 16; const u32x2 hw = *(const u32x2*)(HBi + o); const u32x2 pw = *(const u32x2*)(PP + o);
                        const f32x4 a = acc[ai][bj][m][n]; f32x4 r;
                        r[0] = bflo(hw.x) + fsigmoid(rr * a[0]) * bflo(pw.x); r[1] = bfhi(hw.x) + fsigmoid(rr * a[1]) * bfhi(pw.x); r[2] = bflo(hw.y) + fsigmoid(rr * a[2]) * bflo(pw.y); r[3] = bfhi(hw.y) + fsigmoid(rr * a[3]) * bfhi(pw.y);
                        acc[ai][bj][m][n] = r; sq += (r[0] * r[0] + r[1] * r[1]) + (r[2] * r[2] + r[3] * r[3]); }
                sq += __shfl_xor(sq, 16); sq += __shfl_xor(sq, 32); if (fq == 0) ss_add(SSo + row, sq);
                asm volatile("" ::: "memory"); }
        asm volatile("s_waitcnt vmcnt(0)" ::: "memory");
        unsigned* pc = cnt + 64 * u.pm;
        if (fr == 0 && fq == 0) (void)__hip_atomic_fetch_add(pc, 1u, __ATOMIC_RELAXED, __HIP_MEMORY_SCOPE_AGENT);
        { unsigned spins = 0; while ((unsigned)__builtin_amdgcn_readfirstlane((int)__hip_atomic_load(pc, __ATOMIC_RELAXED, __HIP_MEMORY_SCOPE_AGENT)) < 64u) { __builtin_amdgcn_s_sleep(2); if (++spins > (1u << 20)) break; } }
        asm volatile("" ::: "memory");
#pragma unroll
        for (int ai = 0; ai < 2; ++ai)
#pragma unroll
            for (int m = 0; m < 4; ++m) { const int row = row0 + ai * 128 + m * 16; const size_t off = (size_t)row * D + col0;
                const ss_t tot = __hip_atomic_load(SSo + row, __ATOMIC_RELAXED, __HIP_MEMORY_SCOPE_AGENT); const float rs = rsqrtf((float)tot * (1.0f / (1048576.0f * 2048.0f)) + 1e-6f);
#pragma unroll
                for (int bj = 0; bj < 2; ++bj)
#pragma unroll
                    for (int n = 0; n < 2; ++n) { const int c = bj * 128 + n * 16; const f32x4 g4 = *(const f32x4*)(gfin + col0 + c); *(f32x4*)(out + off + c) = acc[ai][bj][m][n] * rs * g4; } }
    }
};
struct EpiSsdIn {
    static constexpr bool PERM = true;
    bf16_t* Z; bf16_t* XB; const ss_t* SS;
    __device__ __forceinline__ void operator()(const f32x4 (&acc)[2][2][4][2], const Unit& u, int wr, int wc, int fr, int fq) const {
        const int row0 = u.pm * 256 + wr * 64 + fr;
        const bool isz = u.pn < 16; bf16_t* base = isz ? Z : XB; const int ldc = isz ? SSD_INNER : SSD_CONV; const int col0 = (isz ? u.pn : u.pn - 16) * 256 + wc * 32 + 8 * fq;
#pragma unroll
        for (int ai = 0; ai < 2; ++ai)
#pragma unroll
            for (int m = 0; m < 4; ++m) { bf16_t* rowp = base + (size_t)(row0 + ai * 128 + m * 16) * ldc + col0; const float rr = ss_rstd(SS + row0 + ai * 128 + m * 16);
#pragma unroll
                for (int bj = 0; bj < 2; ++bj) { const f32x4 v0 = acc[ai][bj][m][0] * rr, v1 = acc[ai][bj][m][1] * rr;
                    u32x4 w; w.x = cvt_pk_bf16(v0[0], v0[1]); w.y = cvt_pk_bf16(v0[2], v0[3]); w.z = cvt_pk_bf16(v1[0], v1[1]); w.w = cvt_pk_bf16(v1[2], v1[3]);
                    *(u32x4*)(rowp + bj * 128) = w; } }
    }
};
struct EpiDtPart {
    static constexpr bool PERM = true;
    float* DTP;
    __device__ __forceinline__ void operator()(const f32x4 (&acc)[2][2][4][2], const Unit& u, int wr, int wc, int fr, int fq) const {
        const int row0 = u.pm * 256 + wr * 64 + fr;
        if (wc < 2) { const int col0 = wc * 32 + 8 * fq;
#pragma unroll
            for (int ai = 0; ai < 2; ++ai)
#pragma unroll
                for (int m = 0; m < 4; ++m) { float* rowp = DTP + (size_t)(row0 + ai * 128 + m * 16) * SSD_H + col0; *(f32x4*)rowp = acc[ai][0][m][0]; *(f32x4*)(rowp + 4) = acc[ai][0][m][1]; } }
    }
};

__device__ __forceinline__ void xpose_item(const float* src, int ld, bf16_t* dst, int K, int k0, LAS float* scr, int lane, const float* gk) {
    if (src) {
#pragma unroll 8
        for (int i = 0; i < 32; ++i) { const int kk = 2 * i + (lane >> 5); scr[kk * 33 + (lane & 31)] = __builtin_nontemporal_load(src + (size_t)(k0 + kk) * ld + (lane & 31)); }
    } else {
#pragma unroll 8
        for (int i = 0; i < 32; ++i) { const int kk = 2 * i + (lane >> 5); scr[kk * 33 + (lane & 31)] = 0.f; }
    }
    const int c = lane & 7;
    f32x4 g0 = (f32x4){1.f, 1.f, 1.f, 1.f}, g1 = g0;
    if (gk) { g0 = *(const f32x4*)(gk + k0 + 8 * c); g1 = *(const f32x4*)(gk + k0 + 8 * c + 4); }
    asm volatile("s_waitcnt lgkmcnt(0)" ::: "memory");
#pragma unroll
    for (int j = 0; j < 4; ++j) { const int n = (lane >> 3) + 8 * j; const LAS float* s = scr + (8 * c) * 33 + n;
        u32x4 o; o.x = cvt_pk_bf16(s[0 * 33] * g0[0], s[1 * 33] * g0[1]); o.y = cvt_pk_bf16(s[2 * 33] * g0[2], s[3 * 33] * g0[3]); o.z = cvt_pk_bf16(s[4 * 33] * g1[0], s[5 * 33] * g1[1]); o.w = cvt_pk_bf16(s[6 * 33] * g1[2], s[7 * 33] * g1[3]);
        *(u32x4*)(dst + (size_t)n * K + k0 + 8 * c) = o; }
    asm volatile("s_waitcnt lgkmcnt(0)" ::: "memory");
}
__device__ __forceinline__ int xpose_all(const float* src, const float* src2, int ld, int K, int ndst, int nsrc, int mode, bf16_t* dst, int it, int NGW, LAS float* scr, int lane, const float* gvec = nullptr) {
    const int nblk = ndst / 32, nitems = (K / 64) * nblk;
    for (; it < nitems; it += NGW) {
        const int kb = it / nblk, nb = it % nblk, n0 = nb * 32; const float* sp;
        if (mode == 0) sp = (n0 < nsrc) ? src + n0 : nullptr;
        else if (mode == 1) { const int unit = n0 >> 8, bj = (n0 >> 7) & 1, cl = n0 & 127; sp = (bj ? src2 : src) + unit * 128 + cl; }
        else if (mode == 3) { const int pn = n0 >> 8, cl = n0 & 255; sp = src + ((pn >> 2) & 1) * 2048 + ((pn & 3) + 4 * (pn >> 3)) * 256 + cl; }
        else { const int unit = n0 >> 8, bj = (n0 >> 7) & 1, cl = n0 & 127; sp = (bj ? src2 : src) + (size_t)(unit >> 1) * 65536 + (unit & 1) * 128 + cl; }
        xpose_item(sp, ld, dst + (size_t)n0 * K, K, kb * 64, scr, lane, gvec);
    }
    return it - nitems;
}
__device__ __forceinline__ void rms_row(const float* xrow, const float* g, bf16_t* orow, int lane) {
    const f32x4* xr = (const f32x4*)xrow + lane; f32x4 v[8]; float s = 0.f;
#pragma unroll
    for (int j = 0; j < 8; ++j) { v[j] = xr[64 * j]; s += (v[j][0] * v[j][0] + v[j][1] * v[j][1]) + (v[j][2] * v[j][2] + v[j][3] * v[j][3]); }
    const float rstd = rsqrtf(wave_sum(s) * (1.f / D) + EPS);
    const f32x4* gr = (const f32x4*)g + lane;
#pragma unroll
    for (int j = 0; j < 8; ++j) { const f32x4 gv = gr[64 * j]; const f32x4 o = v[j] * rstd * gv; u32x2 w; w.x = cvt_pk_bf16(o[0], o[1]); w.y = cvt_pk_bf16(o[2], o[3]); ((u32x2*)orow)[lane + 64 * j] = w; }
}
__device__ __forceinline__ void rms_phase(const float* X, const float* g, bf16_t* O, int gw, int NGW, int lane) {
    for (int m = gw; m < T; m += NGW) rms_row(X + (size_t)m * D, g, O + (size_t)m * D, lane);
}
__device__ __forceinline__ void final_norm_phase(const bf16_t* HB, const float* g, float* out, int gw, int NGW, int lane) {
    for (int m = gw; m < T; m += NGW) {
        const u32x4* hr = (const u32x4*)(HB + (size_t)m * D) + lane; float f[4][8]; float s = 0.f;
#pragma unroll
        for (int j = 0; j < 4; ++j) { const u32x4 v = hr[64 * j]; f[j][0] = bflo(v.x); f[j][1] = bfhi(v.x); f[j][2] = bflo(v.y); f[j][3] = bfhi(v.y); f[j][4] = bflo(v.z); f[j][5] = bfhi(v.z); f[j][6] = bflo(v.w); f[j][7] = bfhi(v.w);
#pragma unroll
            for (int e = 0; e < 8; ++e) s += f[j][e] * f[j][e]; }
        const float rstd = rsqrtf(wave_sum(s) * (1.f / D) + EPS);
        float* orow = out + (size_t)m * D;
#pragma unroll
        for (int j = 0; j < 4; ++j) { const int c0 = 8 * lane + 512 * j; const f32x4 g0 = *(const f32x4*)(g + c0), g1 = *(const f32x4*)(g + c0 + 4);
            *(f32x4*)(orow + c0) = (f32x4){f[j][0] * rstd * g0[0], f[j][1] * rstd * g0[1], f[j][2] * rstd * g0[2], f[j][3] * rstd * g0[3]};
            *(f32x4*)(orow + c0 + 4) = (f32x4){f[j][4] * rstd * g1[0], f[j][5] * rstd * g1[1], f[j][6] * rstd * g1[2], f[j][7] * rstd * g1[3]}; }
    }
}
template <bool SILU>
__device__ __forceinline__ void conv_phase(const bf16_t* src, const float* w, const float* b, bf16_t* dst, int C, int gt, int NGT) {
    const int c8n = C / 8; const int nitems = (T / 16) * c8n;
    for (int it = gt; it < nitems; it += NGT) {
        const int rb = it / c8n, c0 = (it % c8n) * 8, row0 = rb * 16;
        float wt[4][8], bs[8];
#pragma unroll
        for (int k = 0; k < 4; ++k) { const f32x4 w0 = *(const f32x4*)(w + (size_t)k * C + c0), w1 = *(const f32x4*)(w + (size_t)k * C + c0 + 4);
            wt[k][0] = w0[0]; wt[k][1] = w0[1]; wt[k][2] = w0[2]; wt[k][3] = w0[3]; wt[k][4] = w1[0]; wt[k][5] = w1[1]; wt[k][6] = w1[2]; wt[k][7] = w1[3]; }
        { const f32x4 b0 = *(const f32x4*)(b + c0), b1 = *(const f32x4*)(b + c0 + 4); bs[0] = b0[0]; bs[1] = b0[1]; bs[2] = b0[2]; bs[3] = b0[3]; bs[4] = b1[0]; bs[5] = b1[1]; bs[6] = b1[2]; bs[7] = b1[3]; }
        const bool head = (row0 & (SEQ - 1)) == 0;
        const bf16_t* sp = src + (size_t)row0 * C + c0;
        u32x4 x0, x1, x2;
        if (head) { x0 = (u32x4){0u, 0u, 0u, 0u}; x1 = x0; x2 = x0; }
        else { x0 = *(const u32x4*)(sp - (size_t)3 * C); x1 = *(const u32x4*)(sp - (size_t)2 * C); x2 = *(const u32x4*)(sp - (size_t)C); }
#pragma unroll 4
        for (int r = 0; r < 16; ++r) {
            const u32x4 x3 = *(const u32x4*)(sp + (size_t)r * C);
            const unsigned xa[4][4] = {{x0.x, x0.y, x0.z, x0.w}, {x1.x, x1.y, x1.z, x1.w}, {x2.x, x2.y, x2.z, x2.w}, {x3.x, x3.y, x3.z, x3.w}};
            float a[8];
#pragma unroll
            for (int j = 0; j < 8; ++j) a[j] = bs[j];
#pragma unroll
            for (int k = 0; k < 4; ++k)
#pragma unroll
                for (int q = 0; q < 4; ++q) { a[2 * q] += wt[k][2 * q] * bflo(xa[k][q]); a[2 * q + 1] += wt[k][2 * q + 1] * bfhi(xa[k][q]); }
            if (SILU) {
#pragma unroll
                for (int j = 0; j < 8; ++j) a[j] = fsilu(a[j]); }
            u32x4 o; o.x = cvt_pk_bf16(a[0], a[1]); o.y = cvt_pk_bf16(a[2], a[3]); o.z = cvt_pk_bf16(a[4], a[5]); o.w = cvt_pk_bf16(a[6], a[7]);
            *(u32x4*)(dst + (size_t)(row0 + r) * C + c0) = o;
            x0 = x1; x1 = x2; x2 = x3;
        }
    }
}
__device__ __forceinline__ void lru_scan_phase(const bf16_t* DD, const bf16_t* BB, const bf16_t* YG, bf16_t* Y, LAS float* sm, int tid, int bid, int G) {
    const int cq = tid & 7, sub = tid >> 3;
    LAS f32x4* sP = (LAS f32x4*)sm; LAS f32x4* sH = sP + 512;
    for (int w = bid; w < 256; w += G) {
        const int b = w >> 6, ch = (w & 63) * 32 + cq * 4; const size_t base = ((size_t)b * SEQ + (size_t)sub * 32) * D + ch;
        f32x4 P = (f32x4){1.f, 1.f, 1.f, 1.f}, Hh = (f32x4){0.f, 0.f, 0.f, 0.f};
#pragma unroll 8
        for (int t = 0; t < 32; ++t) { const u32x2 dw = *(const u32x2*)(DD + base + (size_t)t * D), bw = *(const u32x2*)(BB + base + (size_t)t * D);
            const f32x4 a = (f32x4){1.f - bflo(dw.x), 1.f - bfhi(dw.x), 1.f - bflo(dw.y), 1.f - bfhi(dw.y)}, bv = (f32x4){bflo(bw.x), bfhi(bw.x), bflo(bw.y), bfhi(bw.y)}; Hh = a * Hh + bv; P = P * a; }
        sP[tid] = P; sH[tid] = Hh;
        __syncthreads();
        f32x4 h = (f32x4){0.f, 0.f, 0.f, 0.f};
        for (int k = 0; k < sub; ++k) h = sP[k * 8 + cq] * h + sH[k * 8 + cq];
#pragma unroll 8
        for (int t = 0; t < 32; ++t) { const u32x2 dw = *(const u32x2*)(DD + base + (size_t)t * D), bw = *(const u32x2*)(BB + base + (size_t)t * D); const u32x2 yg = *(const u32x2*)(YG + base + (size_t)t * D);
            const f32x4 a = (f32x4){1.f - bflo(dw.x), 1.f - bfhi(dw.x), 1.f - bflo(dw.y), 1.f - bfhi(dw.y)}, bv = (f32x4){bflo(bw.x), bfhi(bw.x), bflo(bw.y), bfhi(bw.y)};
            h = a * h + bv; u32x2 o; o.x = cvt_pk_bf16(h[0] * bflo(yg.x), h[1] * bfhi(yg.x)); o.y = cvt_pk_bf16(h[2] * bflo(yg.y), h[3] * bfhi(yg.y)); *(u32x2*)(Y + base + (size_t)t * D) = o; }
        __syncthreads();
    }
}
constexpr int SS_RS = 136;
constexpr int SS_CT = 0, SS_BT = 34816, SS_XT = 69632, SS_XW = 87040, SS_SIN = 104448, SS_CS = 121856, SS_DTV = 122368;
__device__ __forceinline__ void ssd_phase(const bf16_t* XBC, const float* DT  , const ss_t* SSq, const float* dtb, const bf16_t* Z, const float* a_log, const float* d_skip, bf16_t* YS, LAS unsigned char* lds, int tid, int wid, int lane, int bid, int G) {
    const int fr = lane & 15, fq = lane >> 4;
    LAS bf16_t* Ct = (LAS bf16_t*)(lds + SS_CT); LAS bf16_t* Bt = (LAS bf16_t*)(lds + SS_BT); LAS bf16_t* XT = (LAS bf16_t*)(lds + SS_XT); LAS bf16_t* XW = (LAS bf16_t*)(lds + SS_XW);
    LAS bf16_t* Sin = (LAS bf16_t*)(lds + SS_SIN); LAS float* csbuf = (LAS float*)(lds + SS_CS);
    for (int w = bid; w < 256; w += G) {
        const int b = w >> 6, h = w & 63, g = h >> 3;
        const float A = -expf(a_log[h]), Dh = d_skip[h], dtbh = dtb[h];
        f32x4 Sacc[4];
#pragma unroll
        for (int pt = 0; pt < 4; ++pt) Sacc[pt] = (f32x4){0.f, 0.f, 0.f, 0.f};
        u32x4 cr[4], br[4], xr2[2]; float d0 = 0.f, d1 = 0.f;
        const unsigned voffC = (unsigned)(((tid >> 4) * SSD_CONV + 5120 + g * 128 + (tid & 15) * 8) * 2), voffX = (unsigned)(((tid & 127) * SSD_CONV + h * 64 + (tid >> 7) * 8) * 2);
#define SSD_GLOADS(cc) do { const size_t r0_ = (size_t)b * SEQ + (size_t)(cc) * 128; const char* xr_ = (const char*)(XBC + r0_ * SSD_CONV); \
            _Pragma("unroll") for (int k = 0; k < 4; ++k) { const char* kb_ = xr_ + (size_t)k * (32 * SSD_CONV * 2); \
                cr[k] = *(const u32x4*)(kb_ + voffC); br[k] = *(const u32x4*)(kb_ + voffC - 2048); } \
            _Pragma("unroll") for (int k = 0; k < 2; ++k) xr2[k] = *(const u32x4*)(xr_ + voffX + k * 64); \
            } while (0)
#define SSD_DTLOAD(cc) do { const size_t r0_ = (size_t)b * SEQ + (size_t)(cc) * 128; const size_t i0_ = (r0_ + 2 * lane) * SSD_H + h; float s0_ = 0.f, s1_ = 0.f; \
            _Pragma("unroll") for (int q = 0; q < 8; ++q) { s0_ += DT[(size_t)q * T * SSD_H + i0_]; s1_ += DT[(size_t)q * T * SSD_H + i0_ + SSD_H]; } \
            d0 = fsoftplus(ss_rstd(SSq + r0_ + 2 * lane) * s0_ + dtbh); d1 = fsoftplus(ss_rstd(SSq + r0_ + 2 * lane + 1) * s1_ + dtbh); } while (0)
#define SSD_SCAN(buf) do { const int l0 = 2 * lane; const float a0 = A * d0, a1 = A * d1; float incl = a0 + a1; \
            _Pragma("unroll") for (int o = 1; o < 64; o <<= 1) { const float tv = __shfl_up(incl, o); if (lane >= o) incl += tv; } \
            (buf)[l0 + 1] = incl; (buf)[l0] = incl - a1; (buf)[128 + l0] = d0; (buf)[128 + l0 + 1] = d1; } while (0)
        SSD_GLOADS(0);
        if (wid == 0) { SSD_DTLOAD(0); SSD_SCAN(csbuf); SSD_DTLOAD(1); }
        for (int c = 0; c < 16; ++c) {
            const size_t row0 = (size_t)b * SEQ + (size_t)c * 128;
            __syncthreads();
            LAS float* csv = csbuf + (c & 1) * 256; LAS float* dtv = csv + 128;
#pragma unroll
            for (int pt = 0; pt < 4; ++pt) { u32x2 wv; wv.x = cvt_pk_bf16(Sacc[pt][0], Sacc[pt][1]); wv.y = cvt_pk_bf16(Sacc[pt][2], Sacc[pt][3]);
                *(LAS u32x2*)(Sin + (16 * pt + fr) * SS_RS + 16 * wid + 4 * fq) = wv; }
#pragma unroll
            for (int k = 0; k < 4; ++k) { const int it = tid + 512 * k, r = it >> 4, c16 = it & 15;
                *(LAS u32x4*)(Ct + r * SS_RS + c16 * 8) = cr[k]; *(LAS u32x4*)(Bt + r * SS_RS + c16 * 8) = br[k]; }
            const float total = csv[127];
#pragma unroll
            for (int k = 0; k < 2; ++k) { const int it = tid + 512 * k, sx = it & 127, oct = it >> 7; const float dts = dtv[sx], dtw = dts * __expf(total - csv[sx]);
                const unsigned xw[4] = {xr2[k].x, xr2[k].y, xr2[k].z, xr2[k].w};
#pragma unroll
                for (int j = 0; j < 4; ++j) { const float x0 = bflo(xw[j]), x1 = bfhi(xw[j]);
                    const unsigned pa = cvt_pk_bf16(x0 * dts, x1 * dts), pb = cvt_pk_bf16(x0 * dtw, x1 * dtw);
                    XT[(oct * 8 + 2 * j) * SS_RS + sx] = (bf16_t)(pa & 0xffffu); XT[(oct * 8 + 2 * j + 1) * SS_RS + sx] = (bf16_t)(pa >> 16);
                    XW[(oct * 8 + 2 * j) * SS_RS + sx] = (bf16_t)(pb & 0xffffu); XW[(oct * 8 + 2 * j + 1) * SS_RS + sx] = (bf16_t)(pb >> 16); } }
            __syncthreads();
            if (c + 1 < 16) SSD_GLOADS(c + 1);
            if (wid == 0 && c + 1 < 16) { LAS float* nb = csbuf + ((c + 1) & 1) * 256; SSD_SCAN(nb); if (c + 2 < 16) SSD_DTLOAD(c + 2); }
            const int lrow = 16 * wid + fr; const float csl = csv[lrow];

            bf16x8 Cfr[4];
#pragma unroll
            for (int ks = 0; ks < 4; ++ks) Cfr[ks] = *(const LAS bf16x8*)(Ct + lrow * SS_RS + 32 * ks + 8 * fq);
            unsigned gp[8][2];
#pragma unroll
            for (int t = 0; t < 8; ++t) {
                if (t <= wid) {
                    f32x4 acc = (f32x4){0.f, 0.f, 0.f, 0.f};
#pragma unroll
                    for (int ks = 0; ks < 4; ++ks) { const bf16x8 bfr = *(const LAS bf16x8*)(Bt + (16 * t + fr) * SS_RS + 32 * ks + 8 * fq); acc = __builtin_amdgcn_mfma_f32_16x16x32_bf16(bfr, Cfr[ks], acc, 0, 0, 0); }
                    const f32x4 cs4 = *(const LAS f32x4*)(csv + 16 * t + 4 * fq); float v[4];
#pragma unroll
                    for (int r = 0; r < 4; ++r) { const int sx = 16 * t + 4 * fq + r; v[r] = (sx <= lrow) ? acc[r] * __expf(csl - cs4[r]) : 0.f; }
                    gp[t][0] = cvt_pk_bf16(v[0], v[1]); gp[t][1] = cvt_pk_bf16(v[2], v[3]);
                } else { gp[t][0] = 0u; gp[t][1] = 0u; }
                __builtin_amdgcn_sched_barrier(0);
            }
            f32x4 accd[4], acco[4];
#pragma unroll
            for (int pt = 0; pt < 4; ++pt) { accd[pt] = (f32x4){0.f, 0.f, 0.f, 0.f}; acco[pt] = (f32x4){0.f, 0.f, 0.f, 0.f}; }
#pragma unroll
            for (int u = 0; u < 4; ++u) {
                if (2 * u <= wid) {
                    u32x4 gq; gq.x = gp[2 * u][0]; gq.y = gp[2 * u][1]; gq.z = gp[2 * u + 1][0]; gq.w = gp[2 * u + 1][1];
                    const bf16x8 gfr = __builtin_bit_cast(bf16x8, gq);
#pragma unroll
                    for (int pt = 0; pt < 4; ++pt) { const u32x2 lo = *(const LAS u32x2*)(XT + (16 * pt + fr) * SS_RS + 32 * u + 4 * fq), hi = *(const LAS u32x2*)(XT + (16 * pt + fr) * SS_RS + 32 * u + 16 + 4 * fq);
                        u32x4 xq; xq.x = lo.x; xq.y = lo.y; xq.z = hi.x; xq.w = hi.y;
                        accd[pt] = __builtin_amdgcn_mfma_f32_16x16x32_bf16(__builtin_bit_cast(bf16x8, xq), gfr, accd[pt], 0, 0, 0); }
                }
                __builtin_amdgcn_sched_barrier(0);
            }
#pragma unroll
            for (int ks = 0; ks < 4; ++ks) {
#pragma unroll
                for (int pt = 0; pt < 4; ++pt) { const bf16x8 sfr = *(const LAS bf16x8*)(Sin + (16 * pt + fr) * SS_RS + 32 * ks + 8 * fq); acco[pt] = __builtin_amdgcn_mfma_f32_16x16x32_bf16(sfr, Cfr[ks], acco[pt], 0, 0, 0); }
                __builtin_amdgcn_sched_barrier(0); }
            {
                const float el = __expf(csl); const size_t grow = row0 + lrow;
#pragma unroll
                for (int pt = 0; pt < 4; ++pt) { const int pc = h * 64 + 16 * pt + 4 * fq;
                    const u32x2 xv = *(const u32x2*)(XBC + grow * SSD_CONV + pc), zv = *(const u32x2*)(Z + grow * SSD_INNER + pc);
                    const float xs[4] = {bflo(xv.x), bfhi(xv.x), bflo(xv.y), bfhi(xv.y)}, zs[4] = {bflo(zv.x), bfhi(zv.x), bflo(zv.y), bfhi(zv.y)}; float y[4];
#pragma unroll
                    for (int r = 0; r < 4; ++r) y[r] = (accd[pt][r] + el * acco[pt][r] + Dh * xs[r]) * fsilu(zs[r]);
                    u32x2 o; o.x = cvt_pk_bf16(y[0], y[1]); o.y = cvt_pk_bf16(y[2], y[3]); *(u32x2*)(YS + grow * SSD_INNER + pc) = o; }
            }
            {
                const float eT = __expf(total);
#pragma unroll
                for (int pt = 0; pt < 4; ++pt) Sacc[pt] = Sacc[pt] * eT;
#pragma unroll
                for (int u = 0; u < 4; ++u) { unsigned short bs[8];
#pragma unroll
                    for (int e = 0; e < 8; ++e) bs[e] = Bt[(32 * u + 8 * fq + e) * SS_RS + 16 * wid + fr];
                    u32x4 bq; bq.x = (unsigned)bs[0] | ((unsigned)bs[1] << 16); bq.y = (unsigned)bs[2] | ((unsigned)bs[3] << 16); bq.z = (unsigned)bs[4] | ((unsigned)bs[5] << 16); bq.w = (unsigned)bs[6] | ((unsigned)bs[7] << 16);
                    const bf16x8 pfr = __builtin_bit_cast(bf16x8, bq);
#pragma unroll
                    for (int pt = 0; pt < 4; ++pt) { const bf16x8 qfr = *(const LAS bf16x8*)(XW + (16 * pt + fr) * SS_RS + 32 * u + 8 * fq); Sacc[pt] = __builtin_amdgcn_mfma_f32_16x16x32_bf16(pfr, qfr, Sacc[pt], 0, 0, 0); }
                    __builtin_amdgcn_sched_barrier(0); }
            }
        }
        __syncthreads();
    }
#undef SSD_GLOADS
#undef SSD_DTLOAD
#undef SSD_SCAN
}
__device__ __forceinline__ void gnorm_phase(bf16_t* YS, const float* ng, int gw, int NGW, int lane) {
    for (int row = gw; row < T; row += NGW) {
        bf16_t* p = YS + (size_t)row * SSD_INNER + lane * 8; u32x4 v[8]; float sq[8];
#pragma unroll
        for (int g = 0; g < 8; ++g) v[g] = *(const u32x4*)(p + g * 512);
#pragma unroll
        for (int g = 0; g < 8; ++g) { const float f0 = bflo(v[g].x), f1 = bfhi(v[g].x), f2 = bflo(v[g].y), f3 = bfhi(v[g].y), f4 = bflo(v[g].z), f5 = bfhi(v[g].z), f6 = bflo(v[g].w), f7 = bfhi(v[g].w);
            sq[g] = ((f0 * f0 + f1 * f1) + (f2 * f2 + f3 * f3)) + ((f4 * f4 + f5 * f5) + (f6 * f6 + f7 * f7)); }
#pragma unroll
        for (int o = 1; o < 64; o <<= 1)
#pragma unroll
            for (int g = 0; g < 8; ++g) sq[g] += __shfl_xor(sq[g], o);
#pragma unroll
        for (int g = 0; g < 8; ++g) { const float rstd = rsqrtf(sq[g] * (1.f / 512.f) + EPS);
            const f32x4 g0 = *(const f32x4*)(ng + g * 512 + lane * 8), g1 = *(const f32x4*)(ng + g * 512 + lane * 8 + 4);
            u32x4 o; o.x = cvt_pk_bf16(bflo(v[g].x) * rstd * g0[0], bfhi(v[g].x) * rstd * g0[1]); o.y = cvt_pk_bf16(bflo(v[g].y) * rstd * g0[2], bfhi(v[g].y) * rstd * g0[3]);
            o.z = cvt_pk_bf16(bflo(v[g].z) * rstd * g1[0], bfhi(v[g].z) * rstd * g1[1]); o.w = cvt_pk_bf16(bflo(v[g].w) * rstd * g1[2], bfhi(v[g].w) * rstd * g1[3]);
            *(u32x4*)(p + g * 512) = o; }
    }
}

#define XB_TMO      128
#define XB_XCNT(j)  (256  + 64 * (j))
#define XB_XSUB(j)  (1280 + 64 * (j))
#define XB_XGEN(j)  (2304 + 64 * (j))
#define XB_TOP      3328
#define XB_TOPGEN   3392
#define XCD_BAR_WORDS 3456
#define XB_SPIN_CAP (1u << 18)
__device__ __forceinline__ unsigned xb_ld(unsigned* p)              { return __hip_atomic_load(p, __ATOMIC_RELAXED, __HIP_MEMORY_SCOPE_AGENT); }
__device__ __forceinline__ unsigned xb_add(unsigned* p, unsigned v) { return __hip_atomic_fetch_add(p, v, __ATOMIC_RELAXED, __HIP_MEMORY_SCOPE_AGENT); }
__device__ __forceinline__ unsigned xb_xcc_id() { return (unsigned)__builtin_amdgcn_s_getreg((3 << 11) | 20) & 0xFu; }
#define XB_SPIN(cond, bar) do { unsigned _sp = 0; while (cond) { __builtin_amdgcn_s_sleep(1); \
    if ((++_sp & 255u) == 0u) { if (xb_ld(&(bar)[XB_TMO])) break; if (_sp > XB_SPIN_CAP) { atomicAdd(&(bar)[XB_TMO], 1u); break; } } } } while (0)
struct XcdBarrier { unsigned* bar; unsigned x; volatile LAS unsigned* st; };
__device__ __forceinline__ XcdBarrier xcd_barrier_post(unsigned* bar, volatile LAS unsigned* st) {
    XcdBarrier b; b.bar = bar; b.x = xb_xcc_id(); b.st = st;
    if (threadIdx.x == 0) (void)xb_add(&bar[XB_XCNT(b.x)], 1u);
    return b;
}
__device__ __forceinline__ void xcd_barrier_complete(unsigned* bar, unsigned x, unsigned& nloc, unsigned& nx) {
    const unsigned G = gridDim.x * gridDim.y * gridDim.z;
    unsigned sum, cnt, mine, sp = 0u;
    for (;;) {
        sum = 0u; cnt = 0u; mine = 0u;
#pragma unroll
        for (unsigned j = 0; j < 16; ++j) { const unsigned c = xb_ld(&bar[XB_XCNT(j)]); sum += c; cnt += (c > 0u) ? 1u : 0u; mine = (j == x) ? c : mine; }
        if (sum == G) break;
        __builtin_amdgcn_s_sleep(1);
        if ((++sp & 255u) == 0u) { if (xb_ld(&bar[XB_TMO])) break; if (sp > XB_SPIN_CAP) { atomicAdd(&bar[XB_TMO], 1u); break; } }
    }
    nloc = mine > 0u ? mine : 1u; nx = cnt > 0u ? cnt : 1u;
}
__device__ __forceinline__ void xcd_barrier(const XcdBarrier& b) {
    asm volatile("s_waitcnt vmcnt(0)" ::: "memory");
    __syncthreads();
    if (threadIdx.x == 0) {
        unsigned* bar = b.bar;
        __builtin_amdgcn_s_waitcnt(0);
        unsigned nloc = b.st[0], nx = b.st[1];
        if (nloc == 0u) { xcd_barrier_complete(bar, b.x, nloc, nx); b.st[0] = nloc; b.st[1] = nx; }
        const unsigned old = xb_add(&bar[XB_XSUB(b.x)], 1u);
        const unsigned gen = old / nloc;
        if (old + 1u == (gen + 1u) * nloc) {
            __builtin_amdgcn_fence(__ATOMIC_RELEASE, "agent");
            asm volatile("s_waitcnt vmcnt(0)" ::: "memory");
            const unsigned og = xb_add(&bar[XB_TOP], 1u);
            const unsigned tg = og / nx;
            if (og + 1u == (tg + 1u) * nx) xb_add(&bar[XB_TOPGEN], 1u);
            else XB_SPIN(xb_ld(&bar[XB_TOPGEN]) == tg, bar);
            __builtin_amdgcn_fence(__ATOMIC_ACQUIRE, "agent");
            xb_add(&bar[XB_XGEN(b.x)], 1u);
            asm volatile("s_waitcnt vmcnt(0)" ::: "memory");
        } else {
            XB_SPIN(xb_ld(&bar[XB_XGEN(b.x)]) == gen, bar);
            __builtin_amdgcn_fence(__ATOMIC_ACQUIRE, "agent");
            asm volatile("s_waitcnt vmcnt(0)" ::: "memory");
        }
    }
    __syncthreads();
}

constexpr int NPH = 25;
#ifndef PHMASK
#define PHMASK 0x1ffffff
#endif
#define PH_ON(k) (((PHMASK) >> (k)) & 1)
#ifndef DUPMASK
#define DUPMASK 0
#endif
#ifndef DUPN
#define DUPN 1
#endif
struct Args { const float* in[28]; float* out; unsigned char* ws; int ph_lo, ph_hi; };

__global__ void __launch_bounds__(512) mega(Args a_byval) {
    extern __shared__ __attribute__((aligned(16))) unsigned char lds_raw[];
    cg::grid_group grid = cg::this_grid();
    const int ph_lo = a_byval.ph_lo, ph_hi = a_byval.ph_hi;
    volatile LAS unsigned* misc = (volatile LAS unsigned*)((LAS unsigned char*)lds_raw + 135168);
    if (threadIdx.x < 2) misc[threadIdx.x] = 0u;
    __syncthreads();
    (void)xcd_barrier_post((unsigned*)(a_byval.ws + WS_BAR), misc);
    for (int ph = ph_lo; ph < ph_hi; ++ph) {
        if ((0x641640u >> ph) & 1u) continue;
        const int reps = (ph == 0) ? 2 : (((DUPMASK >> ph) & 1) ? 1 + DUPN : 1);
        for (int rep = 0; rep < reps; ++rep) {
        const __attribute__((address_space(4))) Args* ap = (const __attribute__((address_space(4))) Args*)__builtin_amdgcn_kernarg_segment_ptr();
        asm volatile("" : "+s"(ap));
        int tid = threadIdx.x; asm volatile("" : "+v"(tid));
#define a (*ap)
        LAS unsigned char* lds = (LAS unsigned char*)lds_raw;
        const int lane = tid & 63, wid = __builtin_amdgcn_readfirstlane(tid >> 6);
        int bid_ = blockIdx.x, G_ = gridDim.x; asm volatile("" : "+s"(bid_), "+s"(G_));
        const int bid = bid_, G = G_, gw = bid * 8 + wid, NGW = G * 8, gt = bid * 512 + tid, NGT = G * 512;
        unsigned char* ws = a.ws;
        const float *x = a.in[0], *p = a.in[1], *norm_mix_g = a.in[2], *norm_ffn_g = a.in[3], *norm_ple_g = a.in[4], *final_g = a.in[5];
        bf16_t* U = (bf16_t*)(ws + WS_U); bf16_t* PB = (bf16_t*)(ws + WS_PB); bf16_t* PP = (bf16_t*)(ws + WS_PP);
        const int layer = (ph >= 12 && ph < 24) ? 1 : 0;

        LAS float* scr = (LAS float*)(lds + wid * 8448);
        const int phx = (ph == 0 && rep == 1) ? 12 : ph;
        switch (phx) {
        case 0: case 12: if (!PH_ON(0)) break; {
            const int lyr = (phx == 12) ? 1 : 0;
            int it = gw;
            if (lyr == 0) {
                it = xpose_all(a.in[6], nullptr, 4096, 2048, 4096, 4096, 3, (bf16_t*)(ws + WS_W_IN), it, NGW, scr, lane);
                it = xpose_all(a.in[9], a.in[11], 256, 256, 4096, 4096, 2, (bf16_t*)(ws + WS_W_GATE), it, NGW, scr, lane);
                it = xpose_all(a.in[14], nullptr, 2048, 2048, 2048, 2048, 0, (bf16_t*)(ws + WS_W_AOUT), it, NGW, scr, lane);
                for (int i = gt; i < 2 * T * PLE / 8; i += NGT) { const f32x4 v0 = ((const f32x4*)p)[2 * i], v1 = ((const f32x4*)p)[2 * i + 1];
                    u32x4 o; o.x = cvt_pk_bf16(v0[0], v0[1]); o.y = cvt_pk_bf16(v0[2], v0[3]); o.z = cvt_pk_bf16(v1[0], v1[1]); o.w = cvt_pk_bf16(v1[2], v1[3]); ((u32x4*)PB)[i] = o; }
            } else {
                it = xpose_all(a.in[15], nullptr, SSD_IN, 2048, SSD_IN, SSD_IN, 0, (bf16_t*)(ws + WS_WB_IN), it, NGW, scr, lane, norm_mix_g + D);
                it = xpose_all(a.in[22], nullptr, 2048, 4096, 2048, 2048, 0, (bf16_t*)(ws + WS_WB_OUT), it, NGW, scr, lane);
            }
            it = xpose_all(a.in[23] + (size_t)lyr * D * DFF, a.in[24] + (size_t)lyr * D * DFF, DFF, 2048, 2 * DFF, 2 * DFF, 1, (bf16_t*)(ws + (lyr ? WS_W_GU : WS_W_GU0)), it, NGW, scr, lane, norm_ffn_g + lyr * D);
            it = xpose_all(a.in[25] + (size_t)lyr * D * DFF, nullptr, 2048, DFF, 2048, 2048, 0, (bf16_t*)(ws + (lyr ? WS_W_D : WS_W_D0)), it, NGW, scr, lane);
            it = xpose_all(a.in[27] + (size_t)lyr * D * D, nullptr, 2048, 2048, 2048, 2048, 0, (bf16_t*)(ws + (lyr ? WS_W_PG1 : WS_W_PG)), it, NGW, scr, lane, norm_ple_g + lyr * D);
            it = xpose_all(a.in[26] + (size_t)lyr * PLE * D, nullptr, 2048, 256, 2048, 2048, 0, (bf16_t*)(ws + (lyr ? WS_W_PP1 : WS_W_PP)), it, NGW, scr, lane);
            if (lyr == 0) { rms_phase(x, norm_mix_g, U, gw, NGW, lane);
                for (int i = gt; i < 6 * T + 1024; i += NGT) ((ss_t*)(ws + WS_SS))[i] = 0ull;   }
        } break;
        case 1: if (!PH_ON(1)) break; {
            pg8::Gemm g{U, (const bf16_t*)(ws + WS_W_IN), T, 4096, 2048, 2048, 2048, 0}; pg8::StaticOrder S; S.init(T, 4096, G, bid);
            EpiXY E{(bf16_t*)(ws + WS_XRPRE), (bf16_t*)(ws + WS_YG)}; pg8::gemm_phase(lds, g, S, E, tid);
        } break;
        case 2: if (!PH_ON(2)) break; if (gt < D) ((float*)(ws + WS_SPT))[gt] = -8.0f * log1pf(expf(-a.in[13][gt]));
            conv_phase<false>((const bf16_t*)(ws + WS_XRPRE), a.in[7], a.in[8], (bf16_t*)(ws + WS_XRC), D, gt, NGT); break;
        case 3: if (!PH_ON(3)) break; {
            pg8::Gemm g{(const bf16_t*)(ws + WS_XRC), (const bf16_t*)(ws + WS_W_GATE), T, 4096, 256, 2048, 256, 2}; pg8::StaticOrder S; S.init(T, 4096, G, bid);
            EpiGates E{(const bf16_t*)(ws + WS_XRC), a.in[10], a.in[12], (const float*)(ws + WS_SPT), (bf16_t*)(ws + WS_AA), (bf16_t*)(ws + WS_BB)}; pg8::gemm_phase(lds, g, S, E, tid);
        } break;
        case 4: if (!PH_ON(4)) break; lru_scan_phase((const bf16_t*)(ws + WS_AA), (const bf16_t*)(ws + WS_BB), (const bf16_t*)(ws + WS_YG), (bf16_t*)(ws + WS_Y), (LAS float*)lds, tid, bid, G); break;
        case 5: if (!PH_ON(5)) break; {
            pg8::Gemm g{(const bf16_t*)(ws + WS_Y), (const bf16_t*)(ws + WS_W_AOUT), T, 2048, 2048, 2048, 2048, 0}; pg8::StaticOrder S; S.init(T, 2048, G, bid);
            EpiResid<true> E{x, U, (ss_t*)(ws + WS_SS)}; pg8::gemm_phase(lds, g, S, E, tid);
        } break;
        case 7: case 19: if (!PH_ON(7)) break; {
            pg8::Gemm g{U, (const bf16_t*)(ws + (layer ? WS_W_GU : WS_W_GU0)), T, 2 * DFF, 2048, 2048, 2048, 0}; pg8::StaticOrder S; S.init(T, 2 * DFF, G, bid);
            EpiSwiGLU E{(bf16_t*)(ws + WS_ACT), (const ss_t*)(ws + WS_SS) + (layer ? 3 : 0) * T}; pg8::gemm_phase(lds, g, S, E, tid);
        } break;
        case 8: case 20: if (!PH_ON(8)) break; {
            pg8::Gemm g{(const bf16_t*)(ws + WS_ACT), (const bf16_t*)(ws + (layer ? WS_W_D : WS_W_D0)), T, 2048, DFF, DFF, DFF, 0}; pg8::StaticOrder S; S.init(T, 2048, G, bid);
            EpiResid<false> E{U, U, (ss_t*)(ws + WS_SS) + (layer ? 4 : 1) * T}; pg8::gemm_phase(lds, g, S, E, tid);
        } break;
        case 11: case 23: if (!PH_ON(11)) break; {
            pg8::StaticOrder S; S.init(T, 2048, G, bid);
            { pg8::Gemm g{PB + (size_t)layer * T * PLE, (const bf16_t*)(ws + (layer ? WS_W_PP1 : WS_W_PP)), T, 2048, 256, 256, 256, 0}; EpiPP4 E{PP}; pg8::gemm_phase(lds, g, S, E, tid); }
            pg8::Gemm g{U, (const bf16_t*)(ws + (layer ? WS_W_PG1 : WS_W_PG)), T, 2048, 2048, 2048, 2048, 0};
            if (layer == 0) { EpiPle<true> E{U, PP, (const ss_t*)(ws + WS_SS) + 1 * T, (bf16_t*)(ws + WS_U2), (ss_t*)(ws + WS_SS) + 2 * T}; pg8::gemm_phase(lds, g, S, E, tid); }
            else if (G == 256) { EpiPleFinal E{U, PP, (const ss_t*)(ws + WS_SS) + 4 * T, (ss_t*)(ws + WS_SS) + 5 * T, (unsigned*)(ws + WS_CNT), final_g, a.out}; pg8::gemm_phase(lds, g, S, E, tid); }
            else { EpiPle<false> E{U, PP, (const ss_t*)(ws + WS_SS) + 4 * T, (bf16_t*)(ws + WS_U2), nullptr}; pg8::gemm_phase(lds, g, S, E, tid); }
        } break;
        case 13: if (!PH_ON(13)) break; {
            pg8::Gemm g{(const bf16_t*)(ws + WS_U2), (const bf16_t*)(ws + WS_WB_IN), T, 10240, 2048, 2048, 2048, 0}; pg8::StaticOrder S; S.init(T, 10240, G, bid);
            EpiSsdIn E{(bf16_t*)(ws + WS_Z), (bf16_t*)(ws + WS_XBCPRE), (const ss_t*)(ws + WS_SS) + 2 * T}; pg8::gemm_phase(lds, g, S, E, tid);
            if (bid < 256) {
                const int ks = bid >> 5;
                pg8::Gemm g2{(const bf16_t*)(ws + WS_U2) + ks * 256, (const bf16_t*)(ws + WS_WB_IN) + (size_t)10240 * 2048 + ks * 256, T, 256, 256, 2048, 2048, 0}; pg8::StaticOrder S2; S2.init(T, 256, 32, bid & 31);
                EpiDtPart E2{(float*)(ws + WS_DTP) + (size_t)ks * T * SSD_H}; pg8::gemm_phase(lds, g2, S2, E2, tid); }
        } break;
        case 14: if (!PH_ON(14)) break; conv_phase<true>((const bf16_t*)(ws + WS_XBCPRE), a.in[16], a.in[17], (bf16_t*)(ws + WS_XBC), SSD_CONV, gt, NGT); break;
        case 15: if (!PH_ON(15)) break; ssd_phase((const bf16_t*)(ws + WS_XBC), (const float*)(ws + WS_DTP), (const ss_t*)(ws + WS_SS) + 2 * T, a.in[18], (const bf16_t*)(ws + WS_Z), a.in[19], a.in[20], (bf16_t*)(ws + WS_YS), lds, tid, wid, lane, bid, G); break;
        case 16: if (!PH_ON(16)) break; gnorm_phase((bf16_t*)(ws + WS_YS), a.in[21], gw, NGW, lane); break;
        case 17: if (!PH_ON(17)) break; {
            pg8::Gemm g{(const bf16_t*)(ws + WS_YS), (const bf16_t*)(ws + WS_WB_OUT), T, 2048, 4096, 4096, 4096, 0}; pg8::StaticOrder S; S.init(T, 2048, G, bid);
            EpiResid<false> E{(const bf16_t*)(ws + WS_U2), U, (ss_t*)(ws + WS_SS) + 3 * T}; pg8::gemm_phase(lds, g, S, E, tid);
        } break;
        case 24: if (!PH_ON(24)) break; if (G != 256) final_norm_phase((const bf16_t*)(ws + WS_U2), final_g, a.out, gw, NGW, lane); break;
        default: break;
        }
        if (rep + 1 < reps) continue;
        if (ph + 1 < ph_hi) { if (ph_hi > 64) grid.sync();   else { XcdBarrier xbar; xbar.bar = (unsigned*)(ws + WS_BAR); xbar.x = xb_xcc_id(); xbar.st = (volatile LAS unsigned*)((LAS unsigned char*)lds_raw + 135168); xcd_barrier(xbar); } }
#undef a
        }
    }
}

extern "C" void kernel_launch(void* const* d_in, const int* in_sizes, int n_in, void* d_out, int out_size, void* d_ws, size_t ws_size, hipStream_t stream) {
    static int grid = 0;
    if (grid == 0) {
        if (n_in != 28 || out_size != T * D || ws_size < WS_END) { fprintf(stderr, "kernel_launch: unexpected shapes (n_in %d out %d ws %zu need %zu)\n", n_in, out_size, ws_size, (size_t)WS_END); grid = -1; return; }
        int dev = 0, cus = 0, per_cu = 0;
        hipGetDevice(&dev); hipDeviceGetAttribute(&cus, hipDeviceAttributeMultiprocessorCount, dev);
        if (hipFuncSetAttribute((const void*)mega, hipFuncAttributeMaxDynamicSharedMemorySize, LDS_BYTES) != hipSuccess) { fprintf(stderr, "kernel_launch: hipFuncSetAttribute failed\n"); grid = -1; return; }
        if (hipOccupancyMaxActiveBlocksPerMultiprocessor(&per_cu, (const void*)mega, 512, LDS_BYTES) != hipSuccess || per_cu < 1) { fprintf(stderr, "kernel_launch: occupancy query failed (%d)\n", per_cu); (void)hipGetLastError(); per_cu = 1; }
        grid = cus * per_cu;
        fprintf(stderr, "kernel_launch: grid %d (cus %d x %d), ws %zu\n", grid, cus, per_cu, ws_size);
    }
    if (grid < 0) return;
    Args a{};
    for (int i = 0; i < 28; ++i) a.in[i] = (const float*)d_in[i];
    a.out = (float*)d_out; a.ws = (unsigned char*)d_ws;
#if ONE_LAUNCH
    if (hipMemsetAsync((unsigned char*)d_ws + WS_BAR, 0, XCD_BAR_WORDS * 4, stream) != hipSuccess) { fprintf(stderr, "kernel_launch: memset of barrier words failed\n"); return; }
    a.ph_lo = 0; a.ph_hi = (grid == 256) ? NPH - 1 : NPH;
    void* kargs[] = {&a};
    hipError_t e = hipLaunchCooperativeKernel((const void*)mega, dim3(grid), dim3(512), kargs, LDS_BYTES, stream);
    if (e != hipSuccess) fprintf(stderr, "cooperative launch failed: %s (grid %d)\n", hipGetErrorString(e), grid);
    return;
#endif
    unsigned char* ws = (unsigned char*)d_ws;
    for (int ph = 0; ph < NPH; ++ph) {
        a.ph_lo = ph; a.ph_hi = ph + 1; hipLaunchKernelGGL(mega, dim3(grid), dim3(512), LDS_BYTES, stream, a); }
}
```
